# Optimizing an MI355X kernel written in HIP

```python
import jax, jax.numpy as jnp
from jax import lax
import numpy as np

D_MODEL = 1024
BATCH = 4
SEQ = 4096
DEPTH = 2

N_BRANCH = 3
POOL_WINDOWS = (2, 4, 8, 16)
POOL_WIDTH = D_MODEL // 2
POOL_GROUP = POOL_WIDTH // len(POOL_WINDOWS)
CONV_WIDTH = D_MODEL // 2
CONV_K = 3
HEAD_DIM = 64
ATTN_GROUPS = ((128, 1), (512, 4), (2048, 16))
HEADS_PER_GROUP = 4
N_HEADS = HEADS_PER_GROUP * len(ATTN_GROUPS)
ATTN_WIDTH = N_HEADS * HEAD_DIM
ATTN_OUT = HEADS_PER_GROUP * HEAD_DIM
ATTN_BLOCK = 128
D_FF = 4 * D_MODEL
EPS = 1e-6
MASK_VALUE = -1e30

OFF_POOL = 0
OFF_CONV_B = OFF_POOL + POOL_WIDTH
OFF_CONV_C = OFF_CONV_B + CONV_WIDTH
OFF_CONV_X = OFF_CONV_C + CONV_WIDTH
OFF_Q = OFF_CONV_X + CONV_WIDTH
OFF_K = OFF_Q + ATTN_WIDTH
OFF_V = OFF_K + ATTN_WIDTH
OFF_GATE = OFF_V + ATTN_WIDTH
IN_COLS = OFF_GATE + N_BRANCH * D_MODEL

kernel_name = "hybrid_pool_conv_dilated_attn_block"


def rms_norm(x, gain):
    xf = x.astype(jnp.float32)
    y = xf * lax.rsqrt(jnp.mean(xf * xf, axis=-1, keepdims=True) + EPS)
    return (y * gain.astype(jnp.float32)).astype(x.dtype)


def multiscale_pool(u, w_mix, scale):
    B, S, _ = u.shape
    cs = jnp.cumsum(u.astype(jnp.float32), axis=1)
    pos = jnp.arange(S)
    diffs = []
    for g, w in enumerate(POOL_WINDOWS):
        c = cs[..., g * POOL_GROUP:(g + 1) * POOL_GROUP]
        lag = jnp.pad(c, ((0, 0), (w, 0), (0, 0)))[:, :S]
        count = jnp.minimum(pos + 1, w).astype(jnp.float32)[None, :, None]
        diffs.append((c - lag) / count - u[..., g * POOL_GROUP:(g + 1) * POOL_GROUP].astype(jnp.float32))
    d = jnp.stack(diffs, axis=2).astype(u.dtype)
    y = jnp.einsum('bsgc,gcd->bsgd', d, w_mix).reshape(B, S, POOL_WIDTH)
    return y * scale


def short_gated_conv(b_gate, c_gate, xin, conv_w):
    S = xin.shape[1]
    u = c_gate * xin
    up = jnp.pad(u, ((0, 0), (CONV_K - 1, 0), (0, 0)))
    y = conv_w[CONV_K - 1] * up[:, CONV_K - 1:CONV_K - 1 + S]
    for j in range(CONV_K - 1):
        y = y + conv_w[j] * up[:, j:j + S]
    return b_gate * y


def dilated_window_attention(q, k, v, window, dilation):
    B, S, H, Dh = q.shape
    span = window // dilation
    assert span <= ATTN_BLOCK
    L = S // dilation
    nb = -(-L // ATTN_BLOCK)
    Lp = nb * ATTN_BLOCK

    def fold(t):
        t = t.reshape(B, L, dilation, H, Dh).transpose(0, 2, 3, 1, 4)
        t = jnp.pad(t, ((0, 0), (0, 0), (0, 0), (0, Lp - L), (0, 0)))
        return t.reshape(B, dilation, H, nb, ATTN_BLOCK, Dh)

    def with_prev(t):
        prev = jnp.pad(t, ((0, 0), (0, 0), (0, 0), (1, 0), (0, 0), (0, 0)))[:, :, :, :nb]
        return jnp.concatenate([prev, t], axis=4)

    qb = fold(q).astype(jnp.float32)
    kc = with_prev(fold(k)).astype(jnp.float32)
    vc = with_prev(fold(v)).astype(jnp.float32)
    s = jnp.einsum('bdhnqc,bdhnkc->bdhnqk', qb, kc) * (Dh ** -0.5)
    qi = jnp.arange(ATTN_BLOCK)[:, None]
    ki = jnp.arange(2 * ATTN_BLOCK)[None, :] - ATTN_BLOCK
    rel = qi - ki
    band = (rel >= 0) & (rel <= span)
    has_prev = (jnp.arange(nb) > 0)[:, None, None] | (ki >= 0)[None]
    mask = band[None] & has_prev
    s = jnp.where(mask, s, MASK_VALUE)
    m = jnp.max(s, axis=-1, keepdims=True)
    p = jnp.exp(s - m)
    den = jnp.sum(p, axis=-1, keepdims=True)
    o = jnp.einsum('bdhnqk,bdhnkc->bdhnqc', p, vc) / den
    lse = (m + jnp.log(den))[..., 0]
    o = o.reshape(B, dilation, H, Lp, Dh)[:, :, :, :L].transpose(0, 3, 1, 2, 4).reshape(B, S, H, Dh)
    lse = lse.reshape(B, dilation, H, Lp)[..., :L].transpose(0, 3, 1, 2).reshape(B, S, H)
    return o.astype(q.dtype), lse


def dilated_mixture_attention(q, k, v):
    B, S = q.shape[:2]
    outs, lses = [], []
    for g, (window, dilation) in enumerate(ATTN_GROUPS):
        hs = slice(g * HEADS_PER_GROUP, (g + 1) * HEADS_PER_GROUP)
        o, lse = dilated_window_attention(q[:, :, hs], k[:, :, hs], v[:, :, hs], window, dilation)
        outs.append(o)
        lses.append(lse)
    wts = jax.nn.softmax(jnp.stack(lses, axis=0), axis=0)
    o = jnp.sum(wts[..., None] * jnp.stack(outs, axis=0).astype(jnp.float32), axis=0)
    return o.reshape(B, S, ATTN_OUT).astype(q.dtype)


def hybrid_layer(x, norm_mix, w_in, b_gate, pool_mix, pool_scale, conv_w, q_gain, k_gain,
                 w_pool_up, w_conv_out, w_attn_up, w_o, norm_mlp, w_ff1, w_ff2):
    B, S, D = x.shape
    h = rms_norm(x, norm_mix)
    z = jnp.einsum('bsd,dc->bsc', h, w_in)
    y_pool = multiscale_pool(z[..., OFF_POOL:OFF_CONV_B], pool_mix, pool_scale)
    y_conv = short_gated_conv(z[..., OFF_CONV_B:OFF_CONV_C], z[..., OFF_CONV_C:OFF_CONV_X],
                              z[..., OFF_CONV_X:OFF_Q], conv_w)
    q = rms_norm(z[..., OFF_Q:OFF_K].reshape(B, S, N_HEADS, HEAD_DIM), q_gain)
    k = rms_norm(z[..., OFF_K:OFF_V].reshape(B, S, N_HEADS, HEAD_DIM), k_gain)
    v = z[..., OFF_V:OFF_GATE].reshape(B, S, N_HEADS, HEAD_DIM)
    y_attn = dilated_mixture_attention(q, k, v)
    gates = jax.nn.sigmoid((z[..., OFF_GATE:] + b_gate).astype(jnp.float32)).astype(x.dtype)
    gates = gates.reshape(B, S, N_BRANCH, D)
    merged = (gates[:, :, 0] * (y_pool @ w_pool_up)
              + gates[:, :, 1] * (y_conv @ w_conv_out)
              + gates[:, :, 2] * (y_attn @ w_attn_up))
    x = x + merged @ w_o
    h2 = rms_norm(x, norm_mlp)
    x = x + jnp.square(jax.nn.relu(h2 @ w_ff1)) @ w_ff2
    return x


def setup_inputs(seed: int = 0) -> dict:
    key = jax.random.key(seed)
    ks = jax.random.split(key, 17)
    L, D = DEPTH, D_MODEL

    def nrm(k, shape, fan_in):
        return jax.random.normal(k, shape, jnp.float32) * (fan_in ** -0.5)

    def gain(k, shape):
        return 1.0 + 0.02 * jax.random.normal(k, shape, jnp.float32)

    return {
        "x": jax.random.normal(ks[0], (BATCH, SEQ, D), jnp.float32),
        "norm_mix": gain(ks[1], (L, D)),
        "w_in": nrm(ks[2], (L, D, IN_COLS), D),
        "b_gate": 0.01 * jax.random.normal(ks[3], (L, N_BRANCH * D), jnp.float32),
        "pool_mix": nrm(ks[4], (L, len(POOL_WINDOWS), POOL_GROUP, POOL_GROUP), POOL_GROUP),
        "pool_scale": gain(ks[5], (L, POOL_WIDTH)),
        "conv_w": nrm(ks[6], (L, CONV_K, CONV_WIDTH), CONV_K),
        "q_gain": gain(ks[7], (L, HEAD_DIM)),
        "k_gain": gain(ks[8], (L, HEAD_DIM)),
        "w_pool_up": nrm(ks[9], (L, POOL_WIDTH, D), POOL_WIDTH),
        "w_conv_out": nrm(ks[10], (L, CONV_WIDTH, D), CONV_WIDTH),
        "w_attn_up": nrm(ks[11], (L, ATTN_OUT, D), ATTN_OUT),
        "w_o": nrm(ks[12], (L, D, D), D),
        "norm_mlp": gain(ks[13], (L, D)),
        "w_ff1": nrm(ks[14], (L, D, D_FF), D),
        "w_ff2": nrm(ks[15], (L, D_FF, D), D_FF),
    }


def reference(x, norm_mix, w_in, b_gate, pool_mix, pool_scale, conv_w, q_gain, k_gain,
              w_pool_up, w_conv_out, w_attn_up, w_o, norm_mlp, w_ff1, w_ff2):
    for l in range(DEPTH):
        x = hybrid_layer(x, norm_mix[l], w_in[l], b_gate[l], pool_mix[l], pool_scale[l], conv_w[l],
                         q_gain[l], k_gain[l], w_pool_up[l], w_conv_out[l], w_attn_up[l], w_o[l],
                         norm_mlp[l], w_ff1[l], w_ff2[l])
    return x
```

```cpp
#include <hip/hip_runtime.h>
#define CONV_IN_P0 1
#include <cstdio>
#include <cstdint>
namespace pg8 {
#define PG8_LAS __attribute__((address_space(3)))
typedef unsigned short bf16_t;
typedef short bf16x8 __attribute__((ext_vector_type(8)));
typedef float f32x4 __attribute__((ext_vector_type(4)));
typedef unsigned u32x4 __attribute__((ext_vector_type(4)));
constexpr int BM = 256, BK = 64, HALF = 128, HTB = HALF * BK * 2  , STAGE_BYTES = 8 * HTB, NXCD = 8, WGM = 8;

__host__ __device__ __forceinline__ int lds_byte(int r, int c) { const int st = (r >> 4) * 2 + (c >> 5), rr = r & 15, cc = c & 31, ob = rr * 64 + cc * 2; return st * 1024 + (ob ^ (((ob >> 9) & 1) << 5)); }
__host__ __device__ __forceinline__ void stage_rc(int b, int& R, int& C) { const int st = b / 1024, sb = b % 1024, swz = sb ^ (((sb >> 9) & 1) << 5); R = (st >> 1) * 16 + swz / 64; C = (st & 1) * 32 + (swz % 64) / 2; }
__host__ __device__ __forceinline__ int perm32(int rho) { const int n = rho >> 4, i = rho & 15; return 8 * (i >> 2) + 4 * n + (i & 3); }

struct Unit { int pm, pn; };
struct Gemm { const bf16_t* A; const bf16_t* Bt; int M, N, K; };

struct StaticOrder {
    int nM, nN, nwg, G, c;
    __host__ __device__ void init(int M, int N, int G_, int c_) { nM = M / BM; nN = N / BM; nwg = nM * nN; G = G_; c = c_; }
    __host__ __device__ bool next(int i, Unit& u) const {
        const long L = (long)i * G + c; if (L >= nwg) return false;
        int wgid = (int)L; { const int q = nwg / NXCD, r = nwg % NXCD, xcd = wgid % NXCD, off = wgid / NXCD; wgid = (xcd < r ? xcd * (q + 1) : r * (q + 1) + (xcd - r) * q) + off; }
        const int nig = WGM * nN, gid = wgid / nig, fm = gid * WGM, gsz = (nM - fm) < WGM ? (nM - fm) : WGM;
        u.pm = fm + ((wgid % nig) % gsz); u.pn = (wgid % nig) / gsz; return true;
    }
    __device__ __forceinline__ void a_ready(const Unit&) const {}
    __device__ __forceinline__ void done(const Unit&) const {}
};

typedef float f32x2 __attribute__((ext_vector_type(2)));
typedef float f32x2_cv __attribute__((ext_vector_type(2))); typedef __bf16 bf16x2_cv __attribute__((ext_vector_type(2)));
__device__ __forceinline__ unsigned cvt_pk_bf16(float lo, float hi) { const f32x2_cv v = {lo, hi}; return __builtin_bit_cast(unsigned, __builtin_convertvector(v, bf16x2_cv)); }
__device__ __forceinline__ u32x4 pack8(const f32x4 v0, const f32x4 v1) { u32x4 w; w.x = cvt_pk_bf16(v0[0], v0[1]); w.y = cvt_pk_bf16(v0[2], v0[3]); w.z = cvt_pk_bf16(v1[0], v1[1]); w.w = cvt_pk_bf16(v1[2], v1[3]); return w; }
__device__ __forceinline__ f32x4 unpack_lo4(const u32x4 w) { f32x4 r; r[0] = __uint_as_float(w.x << 16); r[1] = __uint_as_float(w.x & 0xffff0000u); r[2] = __uint_as_float(w.y << 16); r[3] = __uint_as_float(w.y & 0xffff0000u); return r; }
__device__ __forceinline__ f32x4 unpack_hi4(const u32x4 w) { f32x4 r; r[0] = __uint_as_float(w.z << 16); r[1] = __uint_as_float(w.z & 0xffff0000u); r[2] = __uint_as_float(w.w << 16); r[3] = __uint_as_float(w.w & 0xffff0000u); return r; }

constexpr float QK_EPS = 1e-6f, NORM_EPS = 1e-6f;
constexpr float Q_PRESCALE = 0.125f * 1.4426950408889634f;
constexpr int MROWS = 16384, DMODEL = 1024;

struct UnitV { int pm, pn; const bf16_t* A; const bf16_t* Bt; int K; int tag; };

__device__ __forceinline__ void load_rstd(const PG8_LAS float* tab, int rloc0, float (&rs)[2][4]) {
#pragma unroll
    for (int ai = 0; ai < 2; ++ai)
#pragma unroll
        for (int m = 0; m < 4; ++m) rs[ai][m] = tab[rloc0 + ai * HALF + m * 16];
}

struct EpiZ {
    static constexpr bool PERM = true, AFTER_DRAIN = false;
    bf16_t *U, *CB, *U2, *Q, *K, *V; const float* qg; const float* kg; const PG8_LAS float* rstab;
    __device__ __forceinline__ void operator()(const f32x4 (&acc)[2][2][4][2], const UnitV& u, int wr, int wc, int fr, int fq) const {
        const int row0 = u.pm * BM + wr * 64 + fr; const int t = u.pn;
        float rs[2][4]; load_rstd(rstab, wr * 64 + fr, rs);
        if (t < 4 || t >= 14) {
            bf16_t* base; int ldc, colt;
            if (t < 2) { base = U; ldc = 512; colt = t * 256; } else if (t < 4) { base = CB; ldc = 512; colt = (t - 2) * 256; } else { base = V; ldc = 768; colt = (t - 14) * 256; }
            const int col0 = colt + wc * 32 + 8 * fq;
#pragma unroll
            for (int ai = 0; ai < 2; ++ai)
#pragma unroll
                for (int m = 0; m < 4; ++m) { bf16_t* rowp = base + (size_t)(row0 + ai * HALF + m * 16) * ldc + col0;
#pragma unroll
                    for (int bj = 0; bj < 2; ++bj) *(u32x4*)(rowp + bj * HALF) = pack8(acc[ai][bj][m][0] * rs[ai][m], acc[ai][bj][m][1] * rs[ai][m]); }
        } else if (t < 8) {
            const int col0 = (t - 4) * 128 + wc * 32 + 8 * fq;
#pragma unroll
            for (int ai = 0; ai < 2; ++ai)
#pragma unroll
                for (int m = 0; m < 4; ++m) { bf16_t* rowp = U2 + (size_t)(row0 + ai * HALF + m * 16) * 512 + col0; const float r2 = rs[ai][m] * rs[ai][m];
                    *(u32x4*)rowp = pack8(acc[ai][0][m][0] * acc[ai][1][m][0] * r2, acc[ai][0][m][1] * acc[ai][1][m][1] * r2); }
        } else {
            const bool isq = t < 11; const int hd = (isq ? t - 8 : t - 11) * 4 + wc;
            bf16_t* base = isq ? Q : K; const float* g = isq ? qg : kg; const float sc = isq ? Q_PRESCALE : 1.0f;
            f32x4 gv[2][2];
#pragma unroll
            for (int bj = 0; bj < 2; ++bj)
#pragma unroll
                for (int n = 0; n < 2; ++n) gv[bj][n] = *(const f32x4*)(g + 32 * bj + 8 * fq + 4 * n) * sc;
#pragma unroll
            for (int ai = 0; ai < 2; ++ai)
#pragma unroll
                for (int m = 0; m < 4; ++m) {
                    float ss = 0.f;
#pragma unroll
                    for (int bj = 0; bj < 2; ++bj)
#pragma unroll
                        for (int n = 0; n < 2; ++n) { const f32x4 x = acc[ai][bj][m][n]; ss += (x[0] * x[0] + x[1] * x[1]) + (x[2] * x[2] + x[3] * x[3]); }
                    ss += __shfl_xor(ss, 16); ss += __shfl_xor(ss, 32);
                    const float rr = rs[ai][m];
                    const float r = rr * __builtin_amdgcn_rsqf(rr * rr * ss * (1.0f / 64.0f) + QK_EPS);
                    bf16_t* rowp = base + (size_t)(row0 + ai * HALF + m * 16) * 768 + hd * 64 + 8 * fq;
#pragma unroll
                    for (int bj = 0; bj < 2; ++bj) *(u32x4*)(rowp + 32 * bj) = pack8(acc[ai][bj][m][0] * r * gv[bj][0], acc[ai][bj][m][1] * r * gv[bj][1]);
                }
        }
    }
};
struct EpiP34 {
    static constexpr bool PERM = true, AFTER_DRAIN = false;
    bf16_t* MG; u32x4* gs; const float* bias; const PG8_LAS float* rstab;
    __device__ __forceinline__ void operator()(const f32x4 (&acc)[2][2][4][2], const UnitV& u, int wr, int wc, int fr, int fq) const {
        unsigned tidx = (unsigned)(((wr * 4 + wc) * 4 + fq) * 16 + fr); asm volatile("" : "+v"(tidx));
        const int row0 = u.pm * BM + wr * 64 + fr;
        if (u.tag & 1) {
#ifdef DUP
          for (int rep_ = 0; rep_ < ((DUP == 50) ? 2 : 1); ++rep_) {
#else
          {
#endif
            const int col0 = u.pn * BM + wc * 32 + 8 * fq;
            u32x4* gsb = gs;
            f32x4 bv[2][2];
#pragma unroll
            for (int bj = 0; bj < 2; ++bj)
#pragma unroll
                for (int n = 0; n < 2; ++n) bv[bj][n] = *(const f32x4*)(bias + col0 + bj * HALF + 4 * n);
            float rs[2][4]; load_rstd(rstab, wr * 64 + fr, rs);
#pragma unroll
            for (int ai = 0; ai < 2; ++ai)
#pragma unroll
                for (int m = 0; m < 4; ++m) rs[ai][m] *= -1.4426950408889634f;
#pragma unroll
            for (int bj = 0; bj < 2; ++bj)
#pragma unroll
                for (int n = 0; n < 2; ++n) bv[bj][n] = bv[bj][n] * -1.4426950408889634f;
#pragma unroll
            for (int ai = 0; ai < 2; ++ai)
#pragma unroll
                for (int m = 0; m < 4; ++m)
#pragma unroll
                    for (int bj = 0; bj < 2; ++bj) { f32x4 v[2];
#pragma unroll
                        for (int n = 0; n < 2; ++n) {
                            const f32x4 a = acc[ai][bj][m][n], b = bv[bj][n]; const f32x2 rs2 = {rs[ai][m], rs[ai][m]}, one2 = {1.0f, 1.0f};
                            const f32x2 x0 = __builtin_elementwise_fma((f32x2){a[0], a[1]}, rs2, (f32x2){b[0], b[1]}), x1 = __builtin_elementwise_fma((f32x2){a[2], a[3]}, rs2, (f32x2){b[2], b[3]});
                            const f32x2 d0 = (f32x2){__builtin_amdgcn_exp2f(x0[0]), __builtin_amdgcn_exp2f(x0[1])} + one2, d1 = (f32x2){__builtin_amdgcn_exp2f(x1[0]), __builtin_amdgcn_exp2f(x1[1])} + one2;
                            v[n] = (f32x4){__builtin_amdgcn_rcpf(d0[0]), __builtin_amdgcn_rcpf(d0[1]), __builtin_amdgcn_rcpf(d1[0]), __builtin_amdgcn_rcpf(d1[1])}; }
                        (gsb + ((ai * 4 + m) * 2 + bj) * 512)[tidx] = pack8(v[0], v[1]); }
          }
        } else {
            const int col0 = u.pn * BM + wc * 32 + 8 * fq; const bool first = (u.tag == 0); const u32x4* gsb = gs;
#pragma unroll
            for (int ai = 0; ai < 2; ++ai) {
                u32x4 gw[4][2], mw[4][2];
#pragma unroll
                for (int m = 0; m < 4; ++m)
#pragma unroll
                    for (int bj = 0; bj < 2; ++bj) { gw[m][bj] = (gsb + ((ai * 4 + m) * 2 + bj) * 512)[tidx];
                        if (!first) mw[m][bj] = *(const u32x4*)(MG + (size_t)(row0 + ai * HALF + m * 16) * 1024 + col0 + bj * HALF); }
                asm volatile("" ::: "memory");
#pragma unroll
                for (int m = 0; m < 4; ++m)
#pragma unroll
                    for (int bj = 0; bj < 2; ++bj) {
                        f32x4 v0 = unpack_lo4(gw[m][bj]) * acc[ai][bj][m][0], v1 = unpack_hi4(gw[m][bj]) * acc[ai][bj][m][1];
                        if (!first) { v0 += unpack_lo4(mw[m][bj]); v1 += unpack_hi4(mw[m][bj]); }
                        *(u32x4*)(MG + (size_t)(row0 + ai * HALF + m * 16) * 1024 + col0 + bj * HALF) = pack8(v0, v1); }
                asm volatile("" ::: "memory");
            }
        }
    }
};
struct EpiResNorm {
    static constexpr bool PERM = true, AFTER_DRAIN = true;
    bf16_t* X; float* outf; float* rsq;
    __device__ __forceinline__ void fused(const f32x4 (&acc)[2][2][4][2], const UnitV& u, int wr, int wc, int fr, int fq, PG8_LAS unsigned char* lds, int wid, int lane) const {
        const int row0 = u.pm * BM + wr * 64 + fr, col0 = u.pn * BM + wc * 32 + 8 * fq;
        PG8_LAS float* P = (PG8_LAS float*)lds;
        u32x4 xb[2][4][2];
#pragma unroll
        for (int ai = 0; ai < 2; ++ai)
#pragma unroll
            for (int m = 0; m < 4; ++m)
#pragma unroll
                for (int bj = 0; bj < 2; ++bj) xb[ai][m][bj] = *(const u32x4*)(X + (size_t)(row0 + ai * HALF + m * 16) * 1024 + col0 + bj * HALF);
        asm volatile("" ::: "memory");
#pragma unroll
        for (int ai = 0; ai < 2; ++ai)
#pragma unroll
            for (int m = 0; m < 4; ++m) { const size_t off = (size_t)(row0 + ai * HALF + m * 16) * 1024 + col0; float ss = 0.f;
#pragma unroll
                for (int bj = 0; bj < 2; ++bj) { const u32x4 bw = xb[ai][m][bj];
                    const f32x4 v0 = unpack_lo4(bw) + acc[ai][bj][m][0], v1 = unpack_hi4(bw) + acc[ai][bj][m][1];
                    if (outf) { *(f32x4*)(outf + off + bj * HALF) = v0; *(f32x4*)(outf + off + bj * HALF + 4) = v1;
#if defined(DUP) && DUP == 60
                        asm volatile("" ::: "memory"); *(f32x4*)(outf + off + bj * HALF) = v0; *(f32x4*)(outf + off + bj * HALF + 4) = v1; asm volatile("" ::: "memory"); *(f32x4*)(outf + off + bj * HALF) = v0; *(f32x4*)(outf + off + bj * HALF + 4) = v1;
#endif
                    }
                    else { *(u32x4*)(X + off + bj * HALF) = pack8(v0, v1);
                        ss += ((v0[0] * v0[0] + v0[1] * v0[1]) + (v0[2] * v0[2] + v0[3] * v0[3])) + ((v1[0] * v1[0] + v1[1] * v1[1]) + (v1[2] * v1[2] + v1[3] * v1[3])); } }
                if (!outf) { ss += __shfl_xor(ss, 16); ss += __shfl_xor(ss, 32); if (fq == 0) P[(ai * HALF + wr * 64 + m * 16 + fr) * 4 + wc] = ss; } }
        if (!outf) {
            asm volatile("s_waitcnt lgkmcnt(0)" ::: "memory"); __builtin_amdgcn_s_barrier(); asm volatile("" ::: "memory");
            const int t = wid * 64 + lane;
            if (t < 256) { const PG8_LAS float* q = P + t * 4; rsq[(size_t)u.pn * MROWS + u.pm * BM + t] = (q[0] + q[1]) + (q[2] + q[3]); }
        }
    }
};
struct EpiRelu2 {
    static constexpr bool PERM = true, AFTER_DRAIN = false;
    bf16_t* H; const PG8_LAS float* rstab;
    __device__ __forceinline__ void operator()(const f32x4 (&acc)[2][2][4][2], const UnitV& u, int wr, int wc, int fr, int fq) const {
        const int row0 = u.pm * BM + wr * 64 + fr, col0 = u.pn * BM + wc * 32 + 8 * fq;
        float rs[2][4]; load_rstd(rstab, wr * 64 + fr, rs);
#pragma unroll
        for (int ai = 0; ai < 2; ++ai)
#pragma unroll
            for (int m = 0; m < 4; ++m) { bf16_t* rowp = H + (size_t)(row0 + ai * HALF + m * 16) * 4096 + col0;
#pragma unroll
                for (int bj = 0; bj < 2; ++bj) { f32x4 v[2];
#pragma unroll
                    for (int n = 0; n < 2; ++n) { const f32x4 x = __builtin_elementwise_max(acc[ai][bj][m][n] * rs[ai][m], (f32x4){0.f, 0.f, 0.f, 0.f}); v[n] = x * x; }
                    *(u32x4*)(rowp + bj * HALF) = pack8(v[0], v[1]); } }
    }
};

template <class Epi, class Sched, bool ALIGN_EPI = false>
__device__ __forceinline__ void gemm_phase_v(PG8_LAS unsigned char* lds, const Sched& S, const Epi& E, const int tid, const unsigned char* wsb) {
    const __amdgpu_buffer_rsrc_t srd = __builtin_amdgcn_make_buffer_rsrc((void*)wsb, (short)0, 0x7FFFFFFF, 0x00020000);
    const int wid = __builtin_amdgcn_readfirstlane(tid >> 6), lane = tid & 63, wr = wid >> 2, wc = wid & 3, fr = lane & 15, fq = lane >> 4;
    const unsigned kstep = (unsigned)(BK * 2);
    const unsigned ldsw = (unsigned)wid * 1024u;
    const int aoff = lds_byte(wr * 64 + fr, fq * 8), boff = lds_byte(wc * 32 + fr, fq * 8);
    unsigned rdA_ = (unsigned)(size_t)lds + (unsigned)aoff, rdB_ = (unsigned)(size_t)lds + 4u * HTB + (unsigned)boff; asm volatile("" : "+v"(rdA_), "+v"(rdB_));
    PG8_LAS unsigned char* const rdA = (PG8_LAS unsigned char*)(size_t)rdA_; PG8_LAS unsigned char* const rdB = (PG8_LAS unsigned char*)(size_t)rdB_;
#define PG8_SA(b, h) (((b) * 2 + (h)) * HTB)
#define PG8_SB(b, h) ((4 + (b) * 2 + (h)) * HTB)
#define PG8_STAGE(bufoff, goff, voff, hs_) do { _Pragma("unroll") for (int _i = 0; _i < 2; ++_i) \
        __builtin_amdgcn_raw_ptr_buffer_load_lds(srd, (PG8_LAS void*)(lds + (bufoff) + ldsw + _i * 8192), 16, (voff), (goff) + (unsigned)_i * ((hs_) >> 1), 0, 0); } while (0)
#define PG8_LDA(dst, b, h) do { _Pragma("unroll") for (int m = 0; m < 4; ++m) _Pragma("unroll") for (int k = 0; k < 2; ++k) dst[m][k] = *(const PG8_LAS bf16x8*)(rdA + PG8_SA(b, h) + m * 2048 + k * 1024); } while (0)
#define PG8_LDB(dst, b, h) do { _Pragma("unroll") for (int n = 0; n < 2; ++n) _Pragma("unroll") for (int k = 0; k < 2; ++k) dst[n][k] = *(const PG8_LAS bf16x8*)(rdB + (PG8_SB(b, h) - 4 * HTB) + n * 2048 + k * 1024); } while (0)
#define PG8_MMA(ai, bj, At, Bt) do { __builtin_amdgcn_s_setprio(1); _Pragma("unroll") for (int m = 0; m < 4; ++m) _Pragma("unroll") for (int n = 0; n < 2; ++n) _Pragma("unroll") for (int k = 0; k < 2; ++k) \
        acc[ai][bj][m][n] = __builtin_amdgcn_mfma_f32_16x16x32_bf16(Bt[n][k], At[m][k], acc[ai][bj][m][n], 0, 0, 0); __builtin_amdgcn_s_setprio(0); } while (0)
#define PG8_MMA0(ai, bj, At, Bt) do { __builtin_amdgcn_s_setprio(1); _Pragma("unroll") for (int m = 0; m < 4; ++m) _Pragma("unroll") for (int n = 0; n < 2; ++n) { \
        acc[ai][bj][m][n] = __builtin_amdgcn_mfma_f32_16x16x32_bf16(Bt[n][0], At[m][0], (f32x4){0.f, 0.f, 0.f, 0.f}, 0, 0, 0); \
        acc[ai][bj][m][n] = __builtin_amdgcn_mfma_f32_16x16x32_bf16(Bt[n][1], At[m][1], acc[ai][bj][m][n], 0, 0, 0); } __builtin_amdgcn_s_setprio(0); } while (0)
#define PG8_WAIT_V(n) asm volatile("s_waitcnt vmcnt(" #n ")" ::: "memory")
#define PG8_WAIT_L(n) asm volatile("s_waitcnt lgkmcnt(" #n ")" ::: "memory")
#define PG8_BAR __builtin_amdgcn_s_barrier()
#define PG8_SCHED __builtin_amdgcn_sched_barrier(0)
#define PG8_MKOFF(u_, vA_, vB_, hs_, pA_, pB_) do { const int K_ = (u_).K; int R_, C_; stage_rc(tid * 16, R_, C_); const int Rb_ = Epi::PERM ? ((R_ & ~31) + perm32(R_ & 31)) : R_; \
        vA_ = (unsigned)(R_ * K_ + C_) * 2u; vB_ = (unsigned)(Rb_ * K_ + C_) * 2u; \
        hs_ = (unsigned)(HALF * K_ * 2); pA_ = (unsigned)((const unsigned char*)(u_).A - wsb) + (unsigned)(u_).pm * (2u * hs_); pB_ = (unsigned)((const unsigned char*)(u_).Bt - wsb) + (unsigned)(u_).pn * (2u * hs_); } while (0)
    UnitV cur, nxt; int ui = 0;
    if (!S.next(0, cur)) return;
    f32x4 acc[2][2][4][2];
    bf16x8 At[4][2], B0[2][2], B1[2][2];
    unsigned vAc, vBc, vAn, vBn, hsc, hsn, cA, cB, nA, nB;
    PG8_MKOFF(cur, vAc, vBc, hsc, cA, cB);
    PG8_STAGE(PG8_SB(0, 0), cB, vBc, hsc); PG8_STAGE(PG8_SB(0, 1), cB + hsc, vBc, hsc); PG8_STAGE(PG8_SA(0, 0), cA, vAc, hsc); PG8_STAGE(PG8_SA(0, 1), cA + hsc, vAc, hsc);
    if (wr == 1) PG8_BAR;
    PG8_WAIT_V(2); PG8_BAR;
    PG8_STAGE(PG8_SB(1, 0), cB + kstep, vBc, hsc); PG8_STAGE(PG8_SA(1, 0), cA + kstep, vAc, hsc); PG8_STAGE(PG8_SB(1, 1), cB + hsc + kstep, vBc, hsc);
    PG8_WAIT_V(6); PG8_BAR;
    for (;;) {
        const bool has_next = S.next(ui + 1, nxt);
        if (!has_next) nxt = cur;
        PG8_MKOFF(nxt, vAn, vBn, hsn, nA, nB);
        const int nt = cur.K / BK;
        for (int t = 0; t < nt; t += 2) {
            const bool last = (t == nt - 2);
            const unsigned a1 = cA + (unsigned)(t + 1) * kstep;
            const unsigned a2 = last ? nA : cA + (unsigned)(t + 2) * kstep, b2 = last ? nB : cB + (unsigned)(t + 2) * kstep;
            const unsigned a3 = a2 + kstep, b3 = b2 + kstep;
            const unsigned hs2 = last ? hsn : hsc;
            const unsigned vA2 = last ? vAn : vAc, vB2 = last ? vBn : vBc;
            PG8_LDB(B0, 0, 0); PG8_LDB(B1, 0, 1); PG8_SCHED; PG8_LDA(At, 0, 0); PG8_STAGE(PG8_SA(1, 1), a1 + hsc, vAc, hsc);
            PG8_WAIT_V(8); PG8_WAIT_L(0); PG8_BAR; if (t == 0) { PG8_MMA0(0, 0, At, B0); PG8_MMA0(0, 1, At, B1); } else { PG8_MMA(0, 0, At, B0); PG8_MMA(0, 1, At, B1); } PG8_BAR; PG8_SCHED;
            PG8_LDA(At, 0, 1); PG8_STAGE(PG8_SB(0, 0), b2, vB2, hs2); PG8_STAGE(PG8_SB(0, 1), b2 + hs2, vB2, hs2); PG8_STAGE(PG8_SA(0, 0), a2, vA2, hs2);
            PG8_WAIT_V(8); PG8_WAIT_L(0); PG8_BAR; if (t == 0) { PG8_MMA0(1, 0, At, B0); PG8_MMA0(1, 1, At, B1); } else { PG8_MMA(1, 0, At, B0); PG8_MMA(1, 1, At, B1); } PG8_BAR; PG8_SCHED;
            PG8_LDB(B0, 1, 0); PG8_LDB(B1, 1, 1); PG8_SCHED; PG8_LDA(At, 1, 0); PG8_STAGE(PG8_SA(0, 1), a2 + hs2, vA2, hs2);
            PG8_WAIT_V(8); PG8_WAIT_L(0); PG8_BAR; PG8_MMA(0, 0, At, B0); PG8_MMA(0, 1, At, B1); PG8_BAR; PG8_SCHED;
            PG8_LDA(At, 1, 1); PG8_STAGE(PG8_SB(1, 0), b3, vB2, hs2); PG8_STAGE(PG8_SB(1, 1), b3 + hs2, vB2, hs2); PG8_STAGE(PG8_SA(1, 0), a3, vA2, hs2);
            PG8_WAIT_V(8); PG8_WAIT_L(0); PG8_BAR; PG8_MMA(1, 0, At, B0); PG8_MMA(1, 1, At, B1); PG8_BAR; PG8_SCHED;
        }
        if constexpr (ALIGN_EPI) { if (wr == 0) PG8_BAR; }
        if constexpr (!Epi::AFTER_DRAIN) { E(acc, cur, wr, wc, fr, fq); }
        if (!has_next) break;
        if constexpr (ALIGN_EPI && Sched::HOOK) S.unit_done(ui, wid);
        cur = nxt; cA = nA; cB = nB; hsc = hsn; vAc = vAn; vBc = vBn; ++ui;
        if constexpr (ALIGN_EPI) { if (wr == 1) PG8_BAR; }
    }
    PG8_WAIT_V(0);
    if constexpr (!ALIGN_EPI) { if (wr == 0) PG8_BAR; }
    PG8_BAR;
    if constexpr (Epi::AFTER_DRAIN) { E.fused(acc, cur, wr, wc, fr, fq, lds, wid, lane); }
#undef PG8_SA
#undef PG8_SB
#undef PG8_STAGE
#undef PG8_LDA
#undef PG8_LDB
#undef PG8_MMA
#undef PG8_MMA0
#undef PG8_WAIT_V
#undef PG8_WAIT_L
#undef PG8_BAR
#undef PG8_SCHED
#undef PG8_MKOFF
}
struct UniformSched {
    static constexpr bool HOOK = false;
    StaticOrder so; const bf16_t* A; const bf16_t* Bt; int K;
    __device__ __forceinline__ void init(const bf16_t* A_, const bf16_t* Bt_, int M, int N, int K_, int G, int c) { so.init(M, N, G, c); A = A_; Bt = Bt_; K = K_; }
    __device__ __forceinline__ bool next(int i, UnitV& u) const { Unit t; if (!so.next(i, t)) return false; u.pm = t.pm; u.pn = t.pn; u.A = A; u.Bt = Bt; u.K = K; u.tag = 0; return true; }
};
}

constexpr int NWAVES = 8, NTHREADS = NWAVES * 64;
constexpr int BATCH = 4, SEQ = 4096, D = 1024, M = BATCH * SEQ, DEPTH = 2;
constexpr int PW = 512, CW = 512, HD = 64, NH = 12, AW = 768, AO = 256, FF = 4096, INC = 7424;
constexpr int OFF_POOL = 0, OFF_CB = 512, OFF_CC = 1024, OFF_CX = 1536, OFF_Q = 2048, OFF_K = 2816, OFF_V = 3584, OFF_G = 4352;
constexpr int NZ = 4352, NG = 3072;
constexpr float RMS_EPS = 1e-6f;

constexpr size_t KiB = 1024, MiB = 1u << 20;
constexpr size_t WS_CTL = 0, CTL_ZERO_BYTES = 64 * KiB;
constexpr size_t WS_WZ = 1 * MiB;
constexpr size_t WS_WG = WS_WZ + (size_t)NZ * D * 2;
constexpr size_t WS_WPU = WS_WG + (size_t)NG * D * 2;
constexpr size_t WS_WCO = WS_WPU + (size_t)D * PW * 2;
constexpr size_t WS_WAU = WS_WCO + (size_t)D * CW * 2;
constexpr size_t WS_WO = WS_WAU + (size_t)D * AO * 2;
constexpr size_t WS_W1 = WS_WO + (size_t)D * D * 2;
constexpr size_t WS_W2 = WS_W1 + (size_t)FF * D * 2;
constexpr size_t WS_WEND = WS_W2 + (size_t)D * FF * 2;
constexpr size_t WS_XN = 36 * MiB;
constexpr size_t WS_U = 68 * MiB, WS_CB = 84 * MiB, WS_U2 = 100 * MiB, WS_Q = 116 * MiB, WS_K = 140 * MiB, WS_V = 164 * MiB;
constexpr size_t WS_H = 68 * MiB;
constexpr size_t HC_BYTES = 2 * MiB;
constexpr size_t HC_MG = 0;
constexpr size_t HC_GS = 512 * KiB;
constexpr size_t HC_YA = 1 * MiB;
constexpr size_t WS_OP = 196 * MiB;
constexpr size_t WS_LP = 220 * MiB;
constexpr size_t WS_DP = 220 * MiB + 768 * KiB;
constexpr size_t WS_YC = WS_DP + 16 * MiB;
constexpr size_t WS_END = WS_YC + 16 * MiB;
constexpr size_t WS_RSQ = WS_END;
static_assert(WS_WEND <= WS_XN && WS_RSQ + 4 * (size_t)M * 4 <= 256 * MiB && WS_V + 24 * MiB <= WS_OP && WS_H + (size_t)M * FF * 2 <= WS_OP, "d_ws map");
static_assert(M % (2 * 256 * 8) == 0, "xprep_rows2 pairs");
constexpr int CW_BAR = 4096, CW_GRP = 8192, CW_XID = 12288, CW_P1 = 12544;

constexpr int RING_OFF = 0, RING_BYTES = 131072;
constexpr int LDSCTL_OFF = RING_BYTES, MISC_OFF = LDSCTL_OFF + 320;
constexpr int RSTAB_OFF = LDSCTL_OFF + 1024;
constexpr int LDS_BYTES = 147456;

#define GAS __attribute__((address_space(1)))
#define LAS __attribute__((address_space(3)))
typedef unsigned short bf16;
typedef unsigned v4u __attribute__((ext_vector_type(4)));
typedef unsigned v2u __attribute__((ext_vector_type(2)));
typedef float f32x4 __attribute__((ext_vector_type(4)));
typedef float f32x16 __attribute__((ext_vector_type(16)));
typedef short bf16x8 __attribute__((ext_vector_type(8)));
typedef short s16x4 __attribute__((ext_vector_type(4)));
typedef GAS unsigned gu32;
#define RLX_AGENT __ATOMIC_RELAXED, __HIP_MEMORY_SCOPE_AGENT
#define LDS_WAIT() asm volatile("s_waitcnt lgkmcnt(0)" ::: "memory")
#define LDS_BARRIER() asm volatile("s_waitcnt lgkmcnt(0)\n\ts_barrier" ::: "memory")
#define VM_WAIT() asm volatile("s_waitcnt vmcnt(0)" ::: "memory")
__device__ __forceinline__ unsigned pk2(float lo, float hi) { return pg8::cvt_pk_bf16(lo, hi); }
__device__ __forceinline__ float bf_lo(unsigned w) { return __uint_as_float(w << 16); }
__device__ __forceinline__ float bf_hi(unsigned w) { return __uint_as_float(w & 0xffff0000u); }

#define XB_TMO      128
#define XB_XCNT(j)  (256  + 64 * (j))
#define XB_XSUB(j)  (1280 + 64 * (j))
#define XB_XGEN(j)  (2304 + 64 * (j))
#define XB_TOP      3328
#define XB_TOPGEN   3392
#define XCD_BAR_WORDS 3456
#define XB_SPIN_CAP (1u << 18)

__device__ __forceinline__ unsigned xb_ld(unsigned* p)              { return __hip_atomic_load(p, __ATOMIC_RELAXED, __HIP_MEMORY_SCOPE_AGENT); }
__device__ __forceinline__ unsigned xb_add(unsigned* p, unsigned v) { return __hip_atomic_fetch_add(p, v, __ATOMIC_RELAXED, __HIP_MEMORY_SCOPE_AGENT); }
__device__ __forceinline__ unsigned xb_xcc_id() { return (unsigned)__builtin_amdgcn_s_getreg((3 << 11) | 20) & 0xFu; }
#define XB_SPIN(cond, bar) do { unsigned _sp = 0; while (cond) { __builtin_amdgcn_s_sleep(1); \
    if ((++_sp & 255u) == 0u) { if (xb_ld(&(bar)[XB_TMO])) break; if (_sp > XB_SPIN_CAP) { atomicAdd(&(bar)[XB_TMO], 1u); break; } } } } while (0)

struct XcdBarrier {
    unsigned* bar; unsigned x; int wave;
    volatile LAS unsigned* st;
};

__device__ __forceinline__ bool xb_lane0() { unsigned o_ = ~0u; asm volatile("" : "+s"(o_)); return __builtin_amdgcn_mbcnt_hi(o_, __builtin_amdgcn_mbcnt_lo(o_, 0u)) == 0u; }
__device__ __forceinline__ XcdBarrier xcd_barrier_post(unsigned* bar, volatile LAS unsigned* st, int wave) {
    XcdBarrier b; b.bar = bar; b.x = xb_xcc_id(); b.st = st; b.wave = wave;
    if (wave == 0 && xb_lane0()) (void)xb_add(&bar[XB_XCNT(b.x)], 1u);
    return b;
}
__device__ __forceinline__ void xcd_barrier_complete(unsigned* bar, unsigned x, unsigned& nloc, unsigned& nx) {
    const unsigned G = gridDim.x * gridDim.y * gridDim.z;
    unsigned sum, cnt, mine, sp = 0u;
    for (;;) {
        sum = 0u; cnt = 0u; mine = 0u;
#pragma unroll
        for (unsigned j = 0; j < 16; ++j) { const unsigned c = xb_ld(&bar[XB_XCNT(j)]); sum += c; cnt += (c > 0u) ? 1u : 0u; mine = (j == x) ? c : mine; }
        if (sum == G) break;
        __builtin_amdgcn_s_sleep(1);
        if ((++sp & 255u) == 0u) { if (xb_ld(&bar[XB_TMO])) break; if (sp > XB_SPIN_CAP) { atomicAdd(&bar[XB_TMO], 1u); break; } }
    }
    nloc = mine > 0u ? mine : 1u; nx = cnt > 0u ? cnt : 1u;
}

template <bool FENCES = true>
__device__ __forceinline__ void xcd_barrier(const XcdBarrier& b) {
    asm volatile("s_waitcnt vmcnt(0)" ::: "memory");
    __syncthreads();
    if (b.wave == 0 && xb_lane0()) {
        unsigned* bar = b.bar;
        __builtin_amdgcn_s_waitcnt(0);
        unsigned nloc = b.st[0], nx = b.st[1];
        if (nloc == 0u) { xcd_barrier_complete(bar, b.x, nloc, nx); b.st[0] = nloc; b.st[1] = nx; }
        const unsigned old = xb_add(&bar[XB_XSUB(b.x)], 1u);
        const unsigned gen = old / nloc;
        if (old + 1u == (gen + 1u) * nloc) {
            if constexpr (FENCES) __builtin_amdgcn_fence(__ATOMIC_RELEASE, "agent");
            asm volatile("s_waitcnt vmcnt(0)" ::: "memory");
            const unsigned og = xb_add(&bar[XB_TOP], 1u);
            const unsigned tg = og / nx;
            if constexpr (FENCES) __builtin_amdgcn_fence(__ATOMIC_ACQUIRE, "agent");
            if (og + 1u == (tg + 1u) * nx) xb_add(&bar[XB_TOPGEN], 1u);
            else XB_SPIN(xb_ld(&bar[XB_TOPGEN]) == tg, bar);
            xb_add(&bar[XB_XGEN(b.x)], 1u);
            asm volatile("s_waitcnt vmcnt(0)" ::: "memory");
        } else {
            if constexpr (FENCES) __builtin_amdgcn_fence(__ATOMIC_ACQUIRE, "agent");
            XB_SPIN(xb_ld(&bar[XB_XGEN(b.x)]) == gen, bar);
            asm volatile("s_waitcnt vmcnt(0)" ::: "memory");
        }
    }
    __syncthreads();
}

__device__ __forceinline__ void group_barrier(const XcdBarrier& b, unsigned* cnt, unsigned target, unsigned* ids) {
    asm volatile("s_waitcnt vmcnt(0)" ::: "memory");
    __syncthreads();
    if (b.wave == 0 && xb_lane0()) {
        __builtin_amdgcn_s_waitcnt(0);
        unsigned same = b.st[2];
        if (same == 0u) { same = 1u;
#pragma unroll
            for (int j = 0; j < 4; ++j) same = (xb_ld(&ids[64 * j]) == b.x + 1u) ? same : 2u;
            b.st[2] = same; }
        if (same != 1u) { __builtin_amdgcn_fence(__ATOMIC_RELEASE, "agent"); asm volatile("s_waitcnt vmcnt(0)" ::: "memory"); }
        (void)xb_add(cnt, 1u);
        __builtin_amdgcn_fence(__ATOMIC_ACQUIRE, "agent");
        XB_SPIN(xb_ld(cnt) < target, b.bar);
        asm volatile("s_waitcnt vmcnt(0)" ::: "memory");
    }
    __syncthreads();
}

__device__ __forceinline__ void split_arrive(const XcdBarrier& b, int wave, unsigned* base, unsigned round) {
    asm volatile("s_waitcnt vmcnt(0)" ::: "memory");
    __builtin_amdgcn_s_barrier();
    if (wave == 0 && xb_lane0()) {
        __builtin_amdgcn_s_waitcnt(0);
        const unsigned nloc = b.st[0];
        const unsigned old = xb_add(&base[64 * b.x], 1u);
        if (old + 1u == round * nloc) {
            __builtin_amdgcn_fence(__ATOMIC_RELEASE, "agent");
            asm volatile("s_waitcnt vmcnt(0)" ::: "memory");
            (void)xb_add(&base[64 * 16], 1u);
        }
    }
}
__device__ __forceinline__ void split_wait(const XcdBarrier& b, int wave, unsigned* base, unsigned round) {
    if (wave == 0 && xb_lane0()) {
        const unsigned nx = b.st[1];
        __builtin_amdgcn_fence(__ATOMIC_ACQUIRE, "agent");
        XB_SPIN(xb_ld(&base[64 * 16]) < round * nx, b.bar);
        asm volatile("s_waitcnt vmcnt(0)" ::: "memory");
    }
    __syncthreads();
}


#ifndef ALIGN_MULTI
#define ALIGN_MULTI true
#endif
#ifndef DUP
#define DUP -1
#endif
#define REPS(k) for (int rep_ = 0; rep_ < ((DUP == (k)) ? 2 : 1); ++rep_)
struct Frame {
    LAS unsigned char* lds;
    volatile LAS unsigned* MISC;
    gu32* ctl;
    int tid, lane, wave;
    int vcu, G;
    unsigned char* ws;
};

__device__ __forceinline__ float wave_sum(float v) {
#pragma unroll
    for (int o = 1; o < 64; o <<= 1) v += __shfl_xor(v, o);
    return v;
}
__device__ __forceinline__ float wave_max(float v) {
#pragma unroll
    for (int o = 1; o < 64; o <<= 1) v = fmaxf(v, __shfl_xor(v, o));
    return v;
}

__device__ __forceinline__ void transpose_item(const float* W, int ldw, int k0, int srccol0, bf16* WT, int K, int destrow0, LAS float* scr, int lane, const float* gain = nullptr) {
    const int kr = lane >> 3, c4 = (lane & 7) * 4;
    f32x4 v[8];
#pragma unroll
    for (int i = 0; i < 8; ++i) v[i] = __builtin_nontemporal_load((const GAS f32x4*)(W + (size_t)(k0 + 8 * i + kr) * ldw + srccol0 + c4));
    if (gain) {
#pragma unroll
        for (int i = 0; i < 8; ++i) v[i] = v[i] * gain[k0 + 8 * i + kr]; }
#pragma unroll
    for (int i = 0; i < 8; ++i) { LAS float* d = scr + (8 * i + kr) * 33 + c4; d[0] = v[i].x; d[1] = v[i].y; d[2] = v[i].z; d[3] = v[i].w; }
    LDS_WAIT(); asm volatile("" ::: "memory");
    const int c = lane & 7;
#pragma unroll
    for (int j = 0; j < 4; ++j) { const int n = (lane >> 3) + 8 * j; const LAS float* s = scr + (8 * c) * 33 + n;
        v4u o; o.x = pk2(s[0 * 33], s[1 * 33]); o.y = pk2(s[2 * 33], s[3 * 33]); o.z = pk2(s[4 * 33], s[5 * 33]); o.w = pk2(s[6 * 33], s[7 * 33]);
        *(GAS v4u*)(WT + (size_t)(destrow0 + n) * K + k0 + 8 * c) = o; }
    LDS_WAIT(); asm volatile("" ::: "memory");
}
__device__ __forceinline__ int wz_src_col(int rb) {
    const int tile = rb >> 3, pb = rb & 7;
    if (tile < 4) return tile * 256 + pb * 32;
    if (tile < 8) return ((pb >> 2) ? OFF_CX : OFF_CC) + (tile - 4) * 128 + (pb & 3) * 32;
    if (tile < 14) { const int wc = pb & 3, bj = pb >> 2; return OFF_Q + (tile - 8) * 256 + 64 * wc + 32 * bj; }
    return OFF_V + (tile - 14) * 256 + pb * 32;
}
__device__ __forceinline__ void xprep_rows2(const float* x, bf16* xo, float* rsq, int row0, int row1, int lane) {
    const GAS f32x4* xa = (const GAS f32x4*)(x + (size_t)row0 * D) + lane; const GAS f32x4* xb = (const GAS f32x4*)(x + (size_t)row1 * D) + lane;
    f32x4 va[4], vb[4];
#pragma unroll
    for (int j = 0; j < 4; ++j) { va[j] = __builtin_nontemporal_load(xa + 64 * j); vb[j] = __builtin_nontemporal_load(xb + 64 * j); }
    float sa = 0.f, sb = 0.f;
#pragma unroll
    for (int j = 0; j < 4; ++j) { sa += (va[j].x * va[j].x + va[j].y * va[j].y) + (va[j].z * va[j].z + va[j].w * va[j].w); sb += (vb[j].x * vb[j].x + vb[j].y * vb[j].y) + (vb[j].z * vb[j].z + vb[j].w * vb[j].w); }
    sa = wave_sum(sa); sb = wave_sum(sb);
    GAS unsigned long long* oa = (GAS unsigned long long*)(xo + (size_t)row0 * D) + lane; GAS unsigned long long* ob = (GAS unsigned long long*)(xo + (size_t)row1 * D) + lane;
#pragma unroll
    for (int j = 0; j < 4; ++j) { oa[64 * j] = (unsigned long long)pk2(va[j].x, va[j].y) | ((unsigned long long)pk2(va[j].z, va[j].w) << 32);
                                  ob[64 * j] = (unsigned long long)pk2(vb[j].x, vb[j].y) | ((unsigned long long)pk2(vb[j].z, vb[j].w) << 32); }
    if (lane < 4) { rsq[(size_t)lane * M + row0] = (lane == 0) ? sa : 0.f; rsq[(size_t)lane * M + row1] = (lane == 0) ? sb : 0.f; }
}

struct LayerW {
    const float *norm_mix, *w_in, *b_gate, *pool_mix, *pool_scale, *conv_w, *q_gain, *k_gain, *w_pool_up, *w_conv_out, *w_attn_up, *w_o, *norm_mlp, *w_ff1, *w_ff2;
};

__device__ __forceinline__ void convert_weights(Frame& F, const LayerW& L, int part, int gw, int NGW) {
    LAS float* scr = (LAS float*)(F.lds + RING_OFF + F.wave * 16384);
    unsigned char* ws = F.ws;
    constexpr int I_WZ = (NZ / 32) * (D / 64), I_WG = (NG / 32) * (D / 64), I_CO = (D / 32) * (CW / 64), I_AU = (D / 32) * (AO / 64), I_WO = (D / 32) * (D / 64), I_W1 = (FF / 32) * (D / 64), I_W2 = (D / 32) * (FF / 64);
    if (part == 0) {
        for (int r = gw; r < I_WZ; r += NGW) { const int rb = r / (D / 64), kb = r % (D / 64); transpose_item(L.w_in, INC, kb * 64, wz_src_col(rb), (bf16*)(ws + WS_WZ), D, rb * 32, scr, F.lane, L.norm_mix); }
        return;
    }
    constexpr int NITEMS = I_WG + I_CO + I_AU + I_WO + I_W1 + I_W2;
    for (int it = gw; it < NITEMS; it += NGW) {
        int r = it;
        if (r < I_WG) { const int rb = r / (D / 64), kb = r % (D / 64); transpose_item(L.w_in, INC, kb * 64, OFF_G + rb * 32, (bf16*)(ws + WS_WG), D, rb * 32, scr, F.lane, L.norm_mix); continue; } r -= I_WG;
        if (r < I_CO) { const int rb = r / (CW / 64), kb = r % (CW / 64); transpose_item(L.w_conv_out, D, kb * 64, rb * 32, (bf16*)(ws + WS_WCO), CW, rb * 32, scr, F.lane); continue; } r -= I_CO;
        if (r < I_AU) { const int rb = r / (AO / 64), kb = r % (AO / 64); transpose_item(L.w_attn_up, D, kb * 64, rb * 32, (bf16*)(ws + WS_WAU), AO, rb * 32, scr, F.lane); continue; } r -= I_AU;
        if (r < I_WO) { const int rb = r / (D / 64), kb = r % (D / 64); transpose_item(L.w_o, D, kb * 64, rb * 32, (bf16*)(ws + WS_WO), D, rb * 32, scr, F.lane); continue; } r -= I_WO;
        if (r < I_W1) { const int rb = r / (D / 64), kb = r % (D / 64); transpose_item(L.w_ff1, FF, kb * 64, rb * 32, (bf16*)(ws + WS_W1), D, rb * 32, scr, F.lane, L.norm_mlp); continue; } r -= I_W1;
        { const int rb = r / (FF / 64), kb = r % (FF / 64); transpose_item(L.w_ff2, D, kb * 64, rb * 32, (bf16*)(ws + WS_W2), FF, rb * 32, scr, F.lane); }
    }
    for (int grp = gw >> 3; grp < (PW / 64) * (D / 32); grp += NGW >> 3) {
        const int kb = (grp / (D / 32)) * 8 + F.wave, nb = grp % (D / 32), k0 = kb * 8, g = k0 >> 7, n = nb * 32 + (F.lane & 31), dh = (F.lane >> 5) * 64;
        float a[8];
#pragma unroll
        for (int i = 0; i < 8; ++i) a[i] = 0.f;
        const float* mixr = L.pool_mix + (size_t)g * 128 * 128 + (size_t)(k0 & 127) * 128 + dh;
        const float* wp = L.w_pool_up + (size_t)(g * 128 + dh) * D + n; const float* sp = L.pool_scale + g * 128 + dh;
#pragma unroll 8
        for (int d = 0; d < 64; ++d) {
            const float wv = wp[(size_t)d * D] * sp[d];
#pragma unroll
            for (int i = 0; i < 8; ++i) a[i] += mixr[i * 128 + d] * wv;
        }
#pragma unroll
        for (int i = 0; i < 8; ++i) a[i] += __shfl_xor(a[i], 32);
        if (F.lane < 32) { v4u o; o.x = pk2(a[0], a[1]); o.y = pk2(a[2], a[3]); o.z = pk2(a[4], a[5]); o.w = pk2(a[6], a[7]);
            *(GAS v4u*)((bf16*)(ws + WS_WPU) + (size_t)n * PW + k0) = o; }
    }
}

template <int W> __device__ __forceinline__ void pool_run(const bf16* U, bf16* DP, int g, int run, int lane) {
    const int b = run >> 7, t0 = (run & 127) * 32; const size_t rowb = (size_t)b * SEQ;
    const int c = g * 128 + 2 * lane;
    unsigned w[32 + W];
#pragma unroll
    for (int k = 0; k < 32 + W; ++k) { const int tt = t0 - W + k; w[k] = (tt >= 0) ? *(const GAS unsigned*)(U + (rowb + tt) * PW + c) : 0u; }
    float s0 = 0.f, s1 = 0.f;
#pragma unroll
    for (int k = 0; k < W; ++k) { s0 += bf_lo(w[k]); s1 += bf_hi(w[k]); }
#pragma unroll
    for (int k = 0; k < 32; ++k) { const int t = t0 + k; const float n0 = bf_lo(w[W + k]), n1 = bf_hi(w[W + k]);
        s0 += n0 - bf_lo(w[k]); s1 += n1 - bf_hi(w[k]);
        const float inv = 1.0f / (float)((t + 1 < W) ? t + 1 : W);
        *(GAS unsigned*)(DP + (rowb + t) * PW + c) = pk2(s0 * inv - n0, s1 * inv - n1); }
}
__device__ __forceinline__ void conv_run(const bf16* U2, const bf16* CBp, const float* cw, bf16* YC, int run, int lane) {
    const int b = run >> 9, t0 = (run & 511) * 8; const size_t rowb = (size_t)b * SEQ; const int c = 8 * lane;
    v4u uw[10], bw[8];
    const int tw = t0 >= 2 ? t0 - 2 : 0;
    uw[0] = *(const GAS v4u*)(U2 + (rowb + tw) * CW + c); uw[1] = *(const GAS v4u*)(U2 + (rowb + tw + 1) * CW + c);
#pragma unroll
    for (int k = 0; k < 8; ++k) { uw[k + 2] = *(const GAS v4u*)(U2 + (rowb + t0 + k) * CW + c); bw[k] = *(const GAS v4u*)(CBp + (rowb + t0 + k) * CW + c); }
    float w0[8], w1[8], w2[8];
#pragma unroll
    for (int e = 0; e < 8; ++e) { w0[e] = cw[c + e]; w1[e] = cw[CW + c + e]; w2[e] = cw[2 * CW + c + e]; }
    asm volatile("" ::: "memory");
    if (t0 < 2) { uw[0] = (v4u){0u, 0u, 0u, 0u}; uw[1] = (v4u){0u, 0u, 0u, 0u}; }
#define CV_UNPK(q_, f_) do { const v4u t_ = (q_); f_[0] = bf_lo(t_.x); f_[1] = bf_hi(t_.x); f_[2] = bf_lo(t_.y); f_[3] = bf_hi(t_.y); f_[4] = bf_lo(t_.z); f_[5] = bf_hi(t_.z); f_[6] = bf_lo(t_.w); f_[7] = bf_hi(t_.w); } while (0)
#pragma unroll
    for (int k = 0; k < 8; ++k) { float p2[8], p1[8], u[8], bg[8], y[8];
        CV_UNPK(uw[k], p2); CV_UNPK(uw[k + 1], p1); CV_UNPK(uw[k + 2], u); CV_UNPK(bw[k], bg);
#pragma unroll
        for (int e = 0; e < 8; ++e) y[e] = bg[e] * (w2[e] * u[e] + w1[e] * p1[e] + w0[e] * p2[e]);
        v4u o; o.x = pk2(y[0], y[1]); o.y = pk2(y[2], y[3]); o.z = pk2(y[4], y[5]); o.w = pk2(y[6], y[7]);
        *(GAS v4u*)(YC + (rowb + t0 + k) * CW + c) = o; }
#undef CV_UNPK
}

constexpr int KPITCH = 144;
static_assert(384 * (192 + 144) <= RING_BYTES, "attention tiles");
constexpr int VPITCH = 192;
__device__ __forceinline__ int crow(int r, int hi) { return (r & 3) + 8 * (r >> 2) + 4 * hi; }
struct AttnCoord { int b, h, g, dil, rr, i0; };
__device__ __forceinline__ AttnCoord attn_decode(int unit) {
    AttnCoord c; c.b = unit / 192; const int rem = unit % 192; c.h = rem >> 4; const int s = rem & 15; c.g = c.h >> 2; const int lg = 2 * c.g; c.dil = 1 << lg;
    const int nub = 16 >> lg; c.rr = s / nub; c.i0 = (s % nub) * 256; return c;
}
__device__ __forceinline__ void attn_issue(const Frame& F, const AttnCoord& c, v4u (&vv)[6], v4u (&kk)[6], bf16x8 (&qn)[4]) {
    const bf16* Q = (const bf16*)(F.ws + WS_Q); const bf16* K = (const bf16*)(F.ws + WS_K); const bf16* V = (const bf16*)(F.ws + WS_V);
    const size_t rowb = (size_t)c.b * SEQ; const int tid = F.tid, r32 = F.lane & 31, hi = F.lane >> 5;
#pragma unroll
    for (int ps = 0; ps < 6; ++ps) { const int kl = ps * 64 + (tid >> 3), ch = tid & 7, ip = c.i0 - 128 + kl, ipc = ip < 0 ? 0 : ip;
        vv[ps] = *(const GAS v4u*)(V + (rowb + (size_t)ipc * c.dil + c.rr) * AW + c.h * HD + ch * 8);
        kk[ps] = *(const GAS v4u*)(K + (rowb + (size_t)ipc * c.dil + c.rr) * AW + c.h * HD + ch * 8); }
    const int iq = c.i0 + 32 * F.wave + r32;
    const bf16* qp = Q + (rowb + (size_t)iq * c.dil + c.rr) * AW + c.h * HD + 8 * hi;
#pragma unroll
    for (int d0 = 0; d0 < 4; ++d0) qn[d0] = *(const GAS bf16x8*)(qp + 16 * d0);
}
__device__ __forceinline__ void attn_units(Frame& F, int u0, int du, int nu, float Cc) {
    bf16* OP = (bf16*)(F.ws + WS_OP); float* LP = (float*)(F.ws + WS_LP);
    LAS unsigned char* Vs = F.lds + RING_OFF; LAS unsigned char* Ks = Vs + 384 * VPITCH;
    const int tid = F.tid, lane = F.lane, w = F.wave, r32 = lane & 31, hi = lane >> 5;
    v4u vv[6], kk[6]; bf16x8 qn[4];
    if (u0 < nu) attn_issue(F, attn_decode(u0), vv, kk, qn);
#pragma unroll 1
  for (int unit = u0; unit < nu; unit += du) {
    const AttnCoord c = attn_decode(unit);
    const int h = c.h, g = c.g, dil = c.dil, rr = c.rr, i0 = c.i0;
    const size_t rowb = (size_t)c.b * SEQ;
#pragma unroll
    for (int ps = 0; ps < 6; ++ps) { const int kl = ps * 64 + (tid >> 3), ch = tid & 7, ip = i0 - 128 + kl;
        v4u v = vv[ps]; if (ip < 0) v = (v4u){0u, 0u, 0u, 0u};
        *(LAS v4u*)(Vs + kl * VPITCH + ch * 16) = v;
        *(LAS v4u*)(Ks + kl * KPITCH + ch * 16) = kk[ps]; }
    const int iq = i0 + 32 * w + r32;
    bf16x8 qf[4];
#pragma unroll
    for (int d0 = 0; d0 < 4; ++d0) qf[d0] = qn[d0];
    LDS_BARRIER();
    if (unit + du < nu) attn_issue(F, attn_decode(unit + du), vv, kk, qn);
    const LAS unsigned char* kb = Ks + (32 * w + r32) * KPITCH + 16 * hi;
    bf16x8 kfn[4];
#pragma unroll
    for (int d0 = 0; d0 < 4; ++d0) kfn[d0] = *(const LAS bf16x8*)(kb + 32 * d0);
    f32x16 o0 = {}, o1 = {}; float lsum = 0.f;
    const int t4 = r32 - 4 * hi;
    const int trb = (4 * hi + ((lane & 15) >> 2)) * VPITCH + (16 * ((lane >> 4) & 1) + 4 * (lane & 3)) * 2;
#pragma unroll 1
    for (int kt = 0; kt < 5; ++kt) {
        const int kl0 = 32 * w + 32 * kt, ipb = i0 - 128 + kl0;
        bf16x8 kf[4];
#pragma unroll
        for (int d0 = 0; d0 < 4; ++d0) kf[d0] = kfn[d0];
        {
            const int ktn = kt < 4 ? kt + 1 : 4;
#pragma unroll
            for (int d0 = 0; d0 < 4; ++d0) kfn[d0] = *(const LAS bf16x8*)(kb + 32 * ktn * KPITCH + 32 * d0);
        }
        f32x16 sacc = {};
#pragma unroll
        for (int d0 = 0; d0 < 4; ++d0) sacc = __builtin_amdgcn_mfma_f32_32x32x16_bf16(kf[d0], qf[d0], sacc, 0, 0, 0);
        LAS unsigned char* vb = Vs + kl0 * VPITCH + trb;
        bf16x8 vf[4];
#pragma unroll
        for (int db = 0; db < 2; ++db)
#pragma unroll
            for (int st = 0; st < 2; ++st) {
                const s16x4 lo = __builtin_bit_cast(s16x4, __builtin_amdgcn_ds_read_tr16_b64_v4i16((LAS s16x4*)(vb + (16 * st) * VPITCH + db * 64)));
                const s16x4 hi4 = __builtin_bit_cast(s16x4, __builtin_amdgcn_ds_read_tr16_b64_v4i16((LAS s16x4*)(vb + (16 * st + 8) * VPITCH + db * 64)));
                vf[db * 2 + st] = (bf16x8){lo[0], lo[1], lo[2], lo[3], hi4[0], hi4[1], hi4[2], hi4[3]};
            }
        __builtin_amdgcn_sched_barrier(0);
        float p[16];
        if (ipb < 0) {
#pragma unroll
            for (int r = 0; r < 16; ++r) p[r] = 0.f;
        } else if (kt == 0) {
#pragma unroll
            for (int r = 0; r < 16; ++r) { p[r] = (t4 <= (r & 3) + 8 * (r >> 2)) ? __builtin_amdgcn_exp2f(sacc[r] - Cc) : 0.f; lsum += p[r]; }
        } else if (kt == 4) {
#pragma unroll
            for (int r = 0; r < 16; ++r) { p[r] = ((r & 3) + 8 * (r >> 2) <= t4) ? __builtin_amdgcn_exp2f(sacc[r] - Cc) : 0.f; lsum += p[r]; }
        } else {
#pragma unroll
            for (int r = 0; r < 16; ++r) { p[r] = __builtin_amdgcn_exp2f(sacc[r] - Cc); lsum += p[r]; }
        }
        v4u pb0, pb1;
        pb0.x = pk2(p[0], p[1]); pb0.y = pk2(p[2], p[3]); pb0.z = pk2(p[4], p[5]); pb0.w = pk2(p[6], p[7]);
        pb1.x = pk2(p[8], p[9]); pb1.y = pk2(p[10], p[11]); pb1.z = pk2(p[12], p[13]); pb1.w = pk2(p[14], p[15]);
        const bf16x8 pf0 = __builtin_bit_cast(bf16x8, pb0), pf1 = __builtin_bit_cast(bf16x8, pb1);
        asm volatile("" : "+v"(vf[0]), "+v"(vf[1]), "+v"(vf[2]), "+v"(vf[3]));
        o0 = __builtin_amdgcn_mfma_f32_32x32x16_bf16(vf[0], pf0, o0, 0, 0, 0);
        o0 = __builtin_amdgcn_mfma_f32_32x32x16_bf16(vf[1], pf1, o0, 0, 0, 0);
        o1 = __builtin_amdgcn_mfma_f32_32x32x16_bf16(vf[2], pf0, o1, 0, 0, 0);
        o1 = __builtin_amdgcn_mfma_f32_32x32x16_bf16(vf[3], pf1, o1, 0, 0, 0);
    }
    lsum += __shfl_xor(lsum, 32);
    const size_t orow = rowb + (size_t)iq * dil + rr;
    bf16* op = OP + ((size_t)g * M + orow) * AO + (h & 3) * HD;
#pragma unroll
    for (int pr = 0; pr < 4; ++pr) {
        const int ra = 2 * (pr & 1), rb = ra + 1;
        unsigned ax, ay, bx, by;
        if (pr < 2) { ax = pk2(o0[4 * ra], o0[4 * ra + 1]); ay = pk2(o0[4 * ra + 2], o0[4 * ra + 3]); bx = pk2(o0[4 * rb], o0[4 * rb + 1]); by = pk2(o0[4 * rb + 2], o0[4 * rb + 3]); }
        else        { ax = pk2(o1[4 * ra], o1[4 * ra + 1]); ay = pk2(o1[4 * ra + 2], o1[4 * ra + 3]); bx = pk2(o1[4 * rb], o1[4 * rb + 1]); by = pk2(o1[4 * rb + 2], o1[4 * rb + 3]); }
        { const auto r = __builtin_amdgcn_permlane32_swap(ax, bx, false, false); ax = r[0]; bx = r[1]; }
        { const auto r = __builtin_amdgcn_permlane32_swap(ay, by, false, false); ay = r[0]; by = r[1]; }
        v4u o; o.x = ax; o.y = ay; o.z = bx; o.w = by;
        *(GAS v4u*)(op + (pr < 2 ? 0 : 32) + 8 * ra + 8 * hi) = o; }
    if (hi == 0) LP[((size_t)g * M + orow) * 4 + (h & 3)] = lsum;
    LDS_BARRIER();
  }
}
__device__ __forceinline__ void combine_panel(Frame& F, int pm) {
    const bf16* OP = (const bf16*)(F.ws + WS_OP); const float* LP = (const float*)(F.ws + WS_LP); bf16* YA = (bf16*)(F.ws + WS_H + HC_YA + (size_t)pm * (HC_BYTES - 256 * AO * 2));
#pragma unroll 1
    for (int it0 = F.tid; it0 < 256 * 32; it0 += 4 * NTHREADS) {
        v4u w[4][3]; float lp[4][3];
#pragma unroll
        for (int q = 0; q < 4; ++q) { const int it = it0 + q * NTHREADS, m = pm * 256 + (it >> 5), ch = it & 31, j = ch >> 3;
#pragma unroll
            for (int g = 0; g < 3; ++g) { w[q][g] = *(const GAS v4u*)(OP + ((size_t)g * M + m) * AO + ch * 8); lp[q][g] = LP[((size_t)g * M + m) * 4 + j]; } }
        asm volatile("" ::: "memory");
#pragma unroll
        for (int q = 0; q < 4; ++q) { const int it = it0 + q * NTHREADS, m = pm * 256 + (it >> 5), ch = it & 31;
            float acc[8];
#pragma unroll
            for (int e = 0; e < 8; ++e) acc[e] = 0.f;
#pragma unroll
            for (int g = 0; g < 3; ++g) { const v4u x = w[q][g];
                acc[0] += bf_lo(x.x); acc[1] += bf_hi(x.x); acc[2] += bf_lo(x.y); acc[3] += bf_hi(x.y); acc[4] += bf_lo(x.z); acc[5] += bf_hi(x.z); acc[6] += bf_lo(x.w); acc[7] += bf_hi(x.w); }
            const float inv = 1.0f / ((lp[q][0] + lp[q][1]) + lp[q][2]);
            v4u o; o.x = pk2(acc[0] * inv, acc[1] * inv); o.y = pk2(acc[2] * inv, acc[3] * inv); o.z = pk2(acc[4] * inv, acc[5] * inv); o.w = pk2(acc[6] * inv, acc[7] * inv);
            *(GAS v4u*)(YA + (size_t)m * AO + ch * 8) = o; }
    }
}
__device__ __forceinline__ void rstd_panel_to_lds(Frame& F, int pm) {
    if (F.tid < 256) { const float* rsq = (const float*)(F.ws + WS_RSQ) + pm * 256 + F.tid;
        const float s4 = (rsq[0] + rsq[M]) + (rsq[2 * M] + rsq[3 * M]);
        ((LAS float*)(F.lds + RSTAB_OFF))[F.tid] = __builtin_amdgcn_rsqf(s4 * (1.0f / D) + RMS_EPS); }
    LDS_WAIT(); __syncthreads();
}
__device__ __forceinline__ void my_panel(int c, int& pm, int& q) { pm = 8 * (c & 7) + ((c >> 3) & 7); q = c >> 6; }
struct P1Sched {
    static constexpr bool HOOK = true;
    int pm, q; const bf16* A; const bf16* Bt; XcdBarrier xb; unsigned* base; unsigned round;
    __device__ __forceinline__ void unit_done(int ui, int wave) const { if (ui == 3) split_arrive(xb, wave, base, round); }
    __device__ __forceinline__ bool next(int i, pg8::UnitV& u) const {
        const int pn = q + 4 * i; if (pn >= NZ / 256) return false;
        int pm_ = pm; asm volatile("" : "+s"(pm_));
        u.pm = pm_; u.pn = pn; u.A = A; u.Bt = Bt; u.K = D; u.tag = 0; return true;
    }
};
struct P34Sched {
    static constexpr bool HOOK = false;
    int pm, pn; unsigned char* ws;
    __device__ __forceinline__ bool next(int i, pg8::UnitV& u) const {
        if (i >= ((DUP == 51) ? 7 : 6)) return false;
        if (i == 6) i = 4;
        const int br = i >> 1; int pm_ = pm, pn_ = pn; asm volatile("" : "+s"(pm_), "+s"(pn_));
        u.pm = pm_;
        if (!(i & 1)) { u.pn = 4 * br + pn_; u.A = (const bf16*)(ws + WS_XN); u.Bt = (const bf16*)(ws + WS_WG); u.K = D; u.tag = 2 * br + 1; }
        else { const size_t oa = (br == 0) ? WS_DP : (br == 1) ? WS_YC : WS_H + HC_YA + (size_t)pm_ * (HC_BYTES - 256 * AO * 2), ob = (br == 0) ? WS_WPU : (br == 1) ? WS_WCO : WS_WAU;
               u.pn = pn_; u.A = (const bf16*)(ws + oa); u.Bt = (const bf16*)(ws + ob); u.K = (br == 2) ? AO : PW; u.tag = 2 * br; }
        return true;
    }
};

struct Args { const float* in[16]; float* out; unsigned char* ws; };
#define PHASE_BEGIN() Frame F = F0; int lq = l; { int w_ = F0.wave; asm volatile("" : "+s"(w_)); unsigned o_ = ~0u; asm volatile("" : "+s"(o_)); int t_ = w_ * 64 + (int)__builtin_amdgcn_mbcnt_hi(o_, __builtin_amdgcn_mbcnt_lo(o_, 0u)); asm volatile("" : "+v"(t_)); asm volatile("" : "+s"(lq)); F.tid = t_; F.lane = t_ & 63; F.wave = __builtin_amdgcn_readfirstlane(t_ >> 6); } \
    unsigned char* const ws = F.ws; const int gw = F.vcu * NWAVES + F.wave, NGW = F.G * NWAVES; (void)gw; (void)NGW; (void)ws
#define LIN(k, stride) (args.in[k] + (size_t)lq * (stride))
__global__ void __launch_bounds__(NTHREADS, 2) mega_fwd(Args args) {
    extern __shared__ __attribute__((aligned(16))) unsigned char lds[];
    Frame F0;
    F0.lds = (LAS unsigned char*)lds;
    F0.MISC = (volatile LAS unsigned*)(F0.lds + MISC_OFF);
    F0.tid = threadIdx.x; F0.lane = F0.tid & 63; F0.wave = __builtin_amdgcn_readfirstlane(F0.tid >> 6);
    F0.G = gridDim.x; { const int bx = blockIdx.x; F0.vcu = (F0.G % 8 == 0) ? (bx % 8) * (F0.G / 8) + bx / 8 : bx; }
    F0.ws = args.ws; F0.ctl = (gu32*)(args.ws + WS_CTL);
    for (int u = F0.tid; u < (LDS_BYTES - LDSCTL_OFF) / 4; u += NTHREADS) ((LAS unsigned*)(F0.lds + LDSCTL_OFF))[u] = 0u;
    __syncthreads();
    unsigned* const bar_base = (unsigned*)(F0.ctl + CW_BAR);
    XcdBarrier bar = xcd_barrier_post(bar_base, F0.MISC + 8, F0.wave);
    if (F0.wave == 0 && xb_lane0()) (void)xb_add((unsigned*)(F0.ctl + CW_XID) + blockIdx.x, bar.x + 1u);
#define GRID_BAR() do { int w_ = F0.wave; unsigned o_ = CW_BAR; asm volatile("" : "+s"(w_), "+s"(o_)); bar.wave = w_; bar.bar = (unsigned*)(F0.ctl + o_); xcd_barrier(bar); } while (0)
#define EXEC_BAR() do { int w_ = F0.wave; unsigned o_ = CW_BAR; asm volatile("" : "+s"(w_), "+s"(o_)); bar.wave = w_; bar.bar = (unsigned*)(F0.ctl + o_); xcd_barrier<false>(bar); } while (0)
#define GROUP_BAR(n) do { int w_ = F0.wave; unsigned o_ = 0u; asm volatile("" : "+s"(w_), "+s"(o_)); bar.wave = w_; unsigned* const cb_ = (unsigned*)(F0.ctl + o_); bar.bar = cb_ + CW_BAR; \
        group_barrier(bar, cb_ + CW_GRP + 64 * ((int)blockIdx.x & 63), 4u * (unsigned)(n), cb_ + CW_XID + ((int)blockIdx.x & 63)); } while (0)

#pragma unroll 1
    for (int l = 0; l < DEPTH; ++l) {
#define LAYERW(L) LayerW L; L.norm_mix = LIN(1, D); L.w_in = LIN(2, (size_t)D * INC); L.pool_mix = LIN(4, 4 * 128 * 128); L.pool_scale = LIN(5, PW); \
            L.w_pool_up = LIN(9, (size_t)PW * D); L.w_conv_out = LIN(10, (size_t)CW * D); L.w_attn_up = LIN(11, (size_t)AO * D); L.w_o = LIN(12, (size_t)D * D); \
            L.w_ff1 = LIN(14, (size_t)D * FF); L.w_ff2 = LIN(15, (size_t)FF * D); L.norm_mlp = LIN(13, D)
        REPS(0) {
            PHASE_BEGIN();
            LAYERW(L);
            convert_weights(F, L, 0, gw, NGW);
#ifdef CONV_IN_P0
            convert_weights(F, L, 1, gw, NGW);
#endif
            if (lq == 0) for (int m = gw; m < M; m += 2 * NGW) xprep_rows2(args.in[0], (bf16*)(ws + WS_XN), (float*)(ws + WS_RSQ), m, m + NGW, F.lane);
        }
        GRID_BAR();

        REPS(1) {
            PHASE_BEGIN();
            int pm0, q0; my_panel((int)blockIdx.x, pm0, q0);
            rstd_panel_to_lds(F, pm0);
            unsigned o1_ = CW_P1; asm volatile("" : "+s"(o1_)); unsigned* const p1b = (unsigned*)(F0.ctl + o1_);
            P1Sched S{pm0, q0, (const bf16*)(ws + WS_XN), (const bf16*)(ws + WS_WZ), bar, p1b, (unsigned)lq + 1u};
            pg8::EpiZ E{(bf16*)(ws + WS_U), (bf16*)(ws + WS_CB), (bf16*)(ws + WS_U2), (bf16*)(ws + WS_Q), (bf16*)(ws + WS_K), (bf16*)(ws + WS_V), LIN(7, HD), LIN(8, HD), (const LAS float*)(F.lds + RSTAB_OFF)};
            pg8::gemm_phase_v<pg8::EpiZ, P1Sched, ALIGN_MULTI>(F.lds + RING_OFF, S, E, F.tid, ws);
            if (q0 != 0) {
                split_arrive(bar, F.wave, p1b, (unsigned)lq + 1u); split_wait(bar, F.wave, p1b, (unsigned)lq + 1u);
                const int gw2 = ((q0 - 1) * 64 + ((int)blockIdx.x & 63)) * NWAVES + F.wave, NGW2 = 192 * NWAVES;
                for (int it = gw2; it < 2048; it += NGW2) { const int g = it & 3, run = it >> 2; const bf16* U = (const bf16*)(ws + WS_U); bf16* DP = (bf16*)(ws + WS_DP);
                    if (g == 0) pool_run<2>(U, DP, 0, run, F.lane); else if (g == 1) pool_run<4>(U, DP, 1, run, F.lane); else if (g == 2) pool_run<8>(U, DP, 2, run, F.lane); else pool_run<16>(U, DP, 3, run, F.lane); }
                for (int it = gw2; it < 2048; it += NGW2) conv_run((const bf16*)(ws + WS_U2), (const bf16*)(ws + WS_CB), LIN(6, 3 * CW), (bf16*)(ws + WS_YC), it, F.lane);
            }
#ifndef CONV_IN_P0
            constexpr int NFIVE = (M / 256) * (NZ / 256) - 4 * 256;
            if (F.G == 256 && (int)blockIdx.x >= NFIVE) { LAYERW(L); convert_weights(F, L, 1, ((int)blockIdx.x - NFIVE) * NWAVES + F.wave, (256 - NFIVE) * NWAVES); }
            else if (F.G != 256) { LAYERW(L); convert_weights(F, L, 1, gw, NGW); }
#endif
        }
        GRID_BAR();

        REPS(2) {
            PHASE_BEGIN();
            float gg = fabsf(LIN(7, HD)[F.lane] * LIN(8, HD)[F.lane]); gg = wave_max(gg);
            const float Cc = 8.0f * 1.4426950408889634f * gg;
            attn_units(F, F.vcu, F.G, BATCH * NH * 16, Cc);
        }
        GRID_BAR();

        REPS(3) {
            PHASE_BEGIN();
            pg8::StaticOrder so; so.init(M, D, F.G, (int)blockIdx.x); pg8::Unit t0; so.next(0, t0);
            REPS(33) combine_panel(F, t0.pm);
            VM_WAIT(); rstd_panel_to_lds(F, t0.pm);
            P34Sched S{t0.pm, t0.pn, ws};
            pg8::EpiP34 E{(bf16*)(ws + WS_H + HC_MG + (size_t)t0.pm * (HC_BYTES - 256 * D * 2)), (pg8::u32x4*)(ws + WS_H + HC_GS + (size_t)t0.pm * HC_BYTES) + (size_t)t0.pn * 8192, LIN(3, 3 * D), (const LAS float*)(F.lds + RSTAB_OFF)};
            pg8::gemm_phase_v<pg8::EpiP34, P34Sched, ALIGN_MULTI>(F.lds + RING_OFF, S, E, F.tid, ws);
        }
        GROUP_BAR(3 * l + 1);

        {
            PHASE_BEGIN();
            int pm5, q5; my_panel((int)blockIdx.x, pm5, q5);
            pg8::UniformSched S; S.init((const bf16*)(ws + WS_H + HC_MG + (size_t)pm5 * (HC_BYTES - 256 * D * 2)), (const bf16*)(ws + WS_WO), M, D, D, F.G, (int)blockIdx.x);
            pg8::EpiResNorm E{(bf16*)(ws + WS_XN), (float*)nullptr, (float*)(ws + WS_RSQ)};
            pg8::gemm_phase_v<pg8::EpiResNorm, pg8::UniformSched, false>(F.lds + RING_OFF, S, E, F.tid, ws);
        }
        GROUP_BAR(3 * l + 2);
        REPS(6) {
            PHASE_BEGIN();
            pg8::UniformSched S; S.init((const bf16*)(ws + WS_XN), (const bf16*)(ws + WS_W1), M, FF, D, F.G, (int)blockIdx.x);
            { int pm6, q6; my_panel((int)blockIdx.x, pm6, q6); rstd_panel_to_lds(F, pm6); }
            pg8::EpiRelu2 E{(bf16*)(ws + WS_H), (const LAS float*)(F.lds + RSTAB_OFF)};
            pg8::gemm_phase_v<pg8::EpiRelu2, pg8::UniformSched, ALIGN_MULTI>(F.lds + RING_OFF, S, E, F.tid, ws);
        }
        GROUP_BAR(3 * l + 3);
        REPS(40) { if (DUP == 40) { GRID_BAR(); GRID_BAR(); } }
        {
            PHASE_BEGIN();
            pg8::UniformSched S; S.init((const bf16*)(ws + WS_H), (const bf16*)(ws + WS_W2), M, D, FF, F.G, (int)blockIdx.x);
            const bool more = (lq + 1 < DEPTH);
            pg8::EpiResNorm E{(bf16*)(ws + WS_XN), more ? (float*)nullptr : args.out, (float*)(ws + WS_RSQ)};
            pg8::gemm_phase_v<pg8::EpiResNorm, pg8::UniformSched, false>(F.lds + RING_OFF, S, E, F.tid, ws);
        }
        if (l + 1 < DEPTH) EXEC_BAR();
    }
}

extern "C" void kernel_launch(void* const* d_in, const int* in_sizes, int n_in, void* d_out, int out_size, void* d_ws, size_t ws_size, hipStream_t stream) {
    static int grid = 0;
    if (grid == 0) {
        if (n_in != 16 || in_sizes[0] != M * D || out_size != M * D || ws_size < WS_END) { fprintf(stderr, "kernel_launch: unexpected shapes (n_in %d, in0 %d, out %d, ws %zu)\n", n_in, n_in > 0 ? in_sizes[0] : -1, out_size, ws_size); grid = -1; return; }
        int dev = 0, cus = 0, per_cu = 0;
        if (hipGetDevice(&dev) != hipSuccess || hipDeviceGetAttribute(&cus, hipDeviceAttributeMultiprocessorCount, dev) != hipSuccess) { grid = -1; return; }
        if (hipFuncSetAttribute((const void*)mega_fwd, hipFuncAttributeMaxDynamicSharedMemorySize, LDS_BYTES) != hipSuccess) { fprintf(stderr, "kernel_launch: hipFuncSetAttribute failed\n"); grid = -1; return; }
        if (hipOccupancyMaxActiveBlocksPerMultiprocessor(&per_cu, (const void*)mega_fwd, NTHREADS, LDS_BYTES) != hipSuccess || per_cu < 1) fprintf(stderr, "kernel_launch: occupancy query reports %d\n", per_cu);
        (void)hipGetLastError();
        grid = cus;
        if (grid != 256) fprintf(stderr, "kernel_launch: built for a 256-CU device (one output tile per workgroup in three phases); got %d CUs: results will be wrong\n", grid);
    }
    if (grid < 0) return;
    if (hipMemsetAsync((char*)d_ws + WS_CTL, 0, CTL_ZERO_BYTES, stream) != hipSuccess) { fprintf(stderr, "kernel_launch: memset failed\n"); return; }
    Args a{};
    for (int i = 0; i < 16; ++i) a.in[i] = (const float*)d_in[i];
    a.out = (float*)d_out; a.ws = (unsigned char*)d_ws;
    hipLaunchKernelGGL(mega_fwd, dim3(grid), dim3(NTHREADS), LDS_BYTES, stream, a);
    const hipError_t le = hipPeekAtLastError();
    if (le != hipSuccess) fprintf(stderr, "kernel_launch: launch failed: %s\n", hipGetErrorName(le));
}
```

```cpp
#include <hip/hip_runtime.h>
#define CONV_IN_P0 1
#include <cstdio>
#include <cstdint>
namespace pg8 {
#define PG8_LAS __attribute__((address_space(3)))
typedef unsigned short bf16_t;
typedef short bf16x8 __attribute__((ext_vector_type(8)));
typedef float f32x4 __attribute__((ext_vector_type(4)));
typedef unsigned u32x4 __attribute__((ext_vector_type(4)));
constexpr int BM = 256, BK = 64, HALF = 128, HTB = HALF * BK * 2  , STAGE_BYTES = 8 * HTB, NXCD = 8, WGM = 8;

__host__ __device__ __forceinline__ int lds_byte(int r, int c) { const int st = (r >> 4) * 2 + (c >> 5), rr = r & 15, cc = c & 31, ob = rr * 64 + cc * 2; return st * 1024 + (ob ^ (((ob >> 9) & 1) << 5)); }
__host__ __device__ __forceinline__ void stage_rc(int b, int& R, int& C) { const int st = b / 1024, sb = b % 1024, swz = sb ^ (((sb >> 9) & 1) << 5); R = (st >> 1) * 16 + swz / 64; C = (st & 1) * 32 + (swz % 64) / 2; }
__host__ __device__ __forceinline__ int perm32(int rho) { const int n = rho >> 4, i = rho & 15; return 8 * (i >> 2) + 4 * n + (i & 3); }

struct Unit { int pm, pn; };
struct Gemm { const bf16_t* A; const bf16_t* Bt; int M, N, K; };

struct StaticOrder {
    int nM, nN, nwg, G, c;
    __host__ __device__ void init(int M, int N, int G_, int c_) { nM = M / BM; nN = N / BM; nwg = nM * nN; G = G_; c = c_; }
    __host__ __device__ bool next(int i, Unit& u) const {
        const long L = (long)i * G + c; if (L >= nwg) return false;
        int wgid = (int)L; { const int q = nwg / NXCD, r = nwg % NXCD, xcd = wgid % NXCD, off = wgid / NXCD; wgid = (xcd < r ? xcd * (q + 1) : r * (q + 1) + (xcd - r) * q) + off; }
        const int nig = WGM * nN, gid = wgid / nig, fm = gid * WGM, gsz = (nM - fm) < WGM ? (nM - fm) : WGM;
        u.pm = fm + ((wgid % nig) % gsz); u.pn = (wgid % nig) / gsz; return true;
    }
    __device__ __forceinline__ void a_ready(const Unit&) const {}
    __device__ __forceinline__ void done(const Unit&) const {}
};

typedef float f32x2 __attribute__((ext_vector_type(2)));
typedef float f32x2_cv __attribute__((ext_vector_type(2))); typedef __bf16 bf16x2_cv __attribute__((ext_vector_type(2)));
__device__ __forceinline__ unsigned cvt_pk_bf16(float lo, float hi) { const f32x2_cv v = {lo, hi}; return __builtin_bit_cast(unsigned, __builtin_convertvector(v, bf16x2_cv)); }
__device__ __forceinline__ u32x4 pack8(const f32x4 v0, const f32x4 v1) { u32x4 w; w.x = cvt_pk_bf16(v0[0], v0[1]); w.y = cvt_pk_bf16(v0[2], v0[3]); w.z = cvt_pk_bf16(v1[0], v1[1]); w.w = cvt_pk_bf16(v1[2], v1[3]); return w; }
__device__ __forceinline__ f32x4 unpack_lo4(const u32x4 w) { f32x4 r; r[0] = __uint_as_float(w.x << 16); r[1] = __uint_as_float(w.x & 0xffff0000u); r[2] = __uint_as_float(w.y << 16); r[3] = __uint_as_float(w.y & 0xffff0000u); return r; }
__device__ __forceinline__ f32x4 unpack_hi4(const u32x4 w) { f32x4 r; r[0] = __uint_as_float(w.z << 16); r[1] = __uint_as_float(w.z & 0xffff0000u); r[2] = __uint_as_float(w.w << 16); r[3] = __uint_as_float(w.w & 0xffff0000u); return r; }

constexpr float QK_EPS = 1e-6f, NORM_EPS = 1e-6f;
constexpr float Q_PRESCALE = 0.125f * 1.4426950408889634f;
constexpr int MROWS = 16384, DMODEL = 1024;

struct UnitV { int pm, pn; const bf16_t* A; const bf16_t* Bt; int K; int tag; };

__device__ __forceinline__ void load_rstd(const PG8_LAS float* tab, int rloc0, float (&rs)[2][4]) {
#pragma unroll
    for (int ai = 0; ai < 2; ++ai)
#pragma unroll
        for (int m = 0; m < 4; ++m) rs[ai][m] = tab[rloc0 + ai * HALF + m * 16];
}

struct EpiZ {
    static constexpr bool PERM = true, AFTER_DRAIN = false;
    bf16_t *U, *CB, *U2, *Q, *K, *V; const float* qg; const float* kg; const PG8_LAS float* rstab;
    __device__ __forceinline__ void operator()(const f32x4 (&acc)[2][2][4][2], const UnitV& u, int wr, int wc, int fr, int fq) const {
        const int row0 = u.pm * BM + wr * 64 + fr; const int t = u.pn;
        float rs[2][4]; load_rstd(rstab, wr * 64 + fr, rs);
        if (t < 4 || t >= 14) {
            bf16_t* base; int ldc, colt;
            if (t < 2) { base = U; ldc = 512; colt = t * 256; } else if (t < 4) { base = CB; ldc = 512; colt = (t - 2) * 256; } else { base = V; ldc = 768; colt = (t - 14) * 256; }
            const int col0 = colt + wc * 32 + 8 * fq;
#pragma unroll
            for (int ai = 0; ai < 2; ++ai)
#pragma unroll
                for (int m = 0; m < 4; ++m) { bf16_t* rowp = base + (size_t)(row0 + ai * HALF + m * 16) * ldc + col0;
#pragma unroll
                    for (int bj = 0; bj < 2; ++bj) *(u32x4*)(rowp + bj * HALF) = pack8(acc[ai][bj][m][0] * rs[ai][m], acc[ai][bj][m][1] * rs[ai][m]); }
        } else if (t < 8) {
            const int col0 = (t - 4) * 128 + wc * 32 + 8 * fq;
#pragma unroll
            for (int ai = 0; ai < 2; ++ai)
#pragma unroll
                for (int m = 0; m < 4; ++m) { bf16_t* rowp = U2 + (size_t)(row0 + ai * HALF + m * 16) * 512 + col0; const float r2 = rs[ai][m] * rs[ai][m];
                    *(u32x4*)rowp = pack8(acc[ai][0][m][0] * acc[ai][1][m][0] * r2, acc[ai][0][m][1] * acc[ai][1][m][1] * r2); }
        } else {
            const bool isq = t < 11; const int hd = (isq ? t - 8 : t - 11) * 4 + wc;
            bf16_t* base = isq ? Q : K; const float* g = isq ? qg : kg; const float sc = isq ? Q_PRESCALE : 1.0f;
            f32x4 gv[2][2];
#pragma unroll
            for (int bj = 0; bj < 2; ++bj)
#pragma unroll
                for (int n = 0; n < 2; ++n) gv[bj][n] = *(const f32x4*)(g + 32 * bj + 8 * fq + 4 * n) * sc;
#pragma unroll
            for (int ai = 0; ai < 2; ++ai)
#pragma unroll
                for (int m = 0; m < 4; ++m) {
                    float ss = 0.f;
#pragma unroll
                    for (int bj = 0; bj < 2; ++bj)
#pragma unroll
                        for (int n = 0; n < 2; ++n) { const f32x4 x = acc[ai][bj][m][n]; ss += (x[0] * x[0] + x[1] * x[1]) + (x[2] * x[2] + x[3] * x[3]); }
                    ss += __shfl_xor(ss, 16); ss += __shfl_xor(ss, 32);
                    const float rr = rs[ai][m];
                    const float r = rr * __builtin_amdgcn_rsqf(rr * rr * ss * (1.0f / 64.0f) + QK_EPS);
                    bf16_t* rowp = base + (size_t)(row0 + ai * HALF + m * 16) * 768 + hd * 64 + 8 * fq;
#pragma unroll
                    for (int bj = 0; bj < 2; ++bj) *(u32x4*)(rowp + 32 * bj) = pack8(acc[ai][bj][m][0] * r * gv[bj][0], acc[ai][bj][m][1] * r * gv[bj][1]);
                }
        }
    }
};
struct EpiP34 {
    static constexpr bool PERM = true, AFTER_DRAIN = false;
    bf16_t* MG; u32x4* gs; const PG8_LAS float* btab; const PG8_LAS float* rstab;
    __device__ __forceinline__ void operator()(const f32x4 (&acc)[2][2][4][2], const UnitV& u, int wr, int wc, int fr, int fq) const {
        unsigned tidx = (unsigned)(((wr * 4 + wc) * 4 + fq) * 16 + fr); asm volatile("" : "+v"(tidx));
        const int row0 = u.pm * BM + wr * 64 + fr;
        if (u.tag & 1) {
#ifdef DUP
          for (int rep_ = 0; rep_ < ((DUP == 50) ? 2 : 1); ++rep_) {
#else
          {
#endif
            const int col0 = u.pn * BM + wc * 32 + 8 * fq;
            u32x4* gsb = gs;
            f32x4 bv[2][2];
#pragma unroll
            for (int bj = 0; bj < 2; ++bj)
#pragma unroll
                for (int n = 0; n < 2; ++n) bv[bj][n] = *(const PG8_LAS f32x4*)(btab + (u.pn >> 2) * BM + wc * 32 + 8 * fq + bj * HALF + 4 * n);
            float rs[2][4]; load_rstd(rstab, wr * 64 + fr, rs);
#pragma unroll
            for (int ai = 0; ai < 2; ++ai)
#pragma unroll
                for (int m = 0; m < 4; ++m) rs[ai][m] *= -1.4426950408889634f;
#pragma unroll
            for (int ai = 0; ai < 2; ++ai)
#pragma unroll
                for (int m = 0; m < 4; ++m)
#pragma unroll
                    for (int bj = 0; bj < 2; ++bj) { f32x4 v[2];
#pragma unroll
                        for (int n = 0; n < 2; ++n) {
                            const f32x4 a = acc[ai][bj][m][n], b = bv[bj][n]; const f32x2 rs2 = {rs[ai][m], rs[ai][m]}, one2 = {1.0f, 1.0f};
                            const f32x2 x0 = __builtin_elementwise_fma((f32x2){a[0], a[1]}, rs2, (f32x2){b[0], b[1]}), x1 = __builtin_elementwise_fma((f32x2){a[2], a[3]}, rs2, (f32x2){b[2], b[3]});
                            const f32x2 d0 = (f32x2){__builtin_amdgcn_exp2f(x0[0]), __builtin_amdgcn_exp2f(x0[1])} + one2, d1 = (f32x2){__builtin_amdgcn_exp2f(x1[0]), __builtin_amdgcn_exp2f(x1[1])} + one2;
                            v[n] = (f32x4){__builtin_amdgcn_rcpf(d0[0]), __builtin_amdgcn_rcpf(d0[1]), __builtin_amdgcn_rcpf(d1[0]), __builtin_amdgcn_rcpf(d1[1])}; }
                        (gsb + ((ai * 4 + m) * 2 + bj) * 512)[tidx] = pack8(v[0], v[1]); }
          }
        } else {
            const int col0 = u.pn * BM + wc * 32 + 8 * fq; const bool first = (u.tag == 0); const u32x4* gsb = gs;
#pragma unroll
            for (int ai = 0; ai < 2; ++ai) {
                u32x4 gw[4][2], mw[4][2];
#pragma unroll
                for (int m = 0; m < 4; ++m)
#pragma unroll
                    for (int bj = 0; bj < 2; ++bj) { gw[m][bj] = (gsb + ((ai * 4 + m) * 2 + bj) * 512)[tidx];
                        if (!first) mw[m][bj] = *(const u32x4*)(MG + (size_t)(row0 + ai * HALF + m * 16) * 1024 + col0 + bj * HALF); }
                asm volatile("" ::: "memory");
#pragma unroll
                for (int m = 0; m < 4; ++m)
#pragma unroll
                    for (int bj = 0; bj < 2; ++bj) {
                        f32x4 v0 = unpack_lo4(gw[m][bj]) * acc[ai][bj][m][0], v1 = unpack_hi4(gw[m][bj]) * acc[ai][bj][m][1];
                        if (!first) { v0 += unpack_lo4(mw[m][bj]); v1 += unpack_hi4(mw[m][bj]); }
                        *(u32x4*)(MG + (size_t)(row0 + ai * HALF + m * 16) * 1024 + col0 + bj * HALF) = pack8(v0, v1); }
                asm volatile("" ::: "memory");
            }
        }
    }
};
struct EpiResNorm {
    static constexpr bool PERM = true, AFTER_DRAIN = true;
    bf16_t* X; float* outf; float* rsq;
    __device__ __forceinline__ void fused(const f32x4 (&acc)[2][2][4][2], const UnitV& u, int wr, int wc, int fr, int fq, PG8_LAS unsigned char* lds, int wid, int lane) const {
        const int row0 = u.pm * BM + wr * 64 + fr, col0 = u.pn * BM + wc * 32 + 8 * fq;
        PG8_LAS float* P = (PG8_LAS float*)lds;
        u32x4 xb[2][4][2];
#pragma unroll
        for (int ai = 0; ai < 2; ++ai)
#pragma unroll
            for (int m = 0; m < 4; ++m)
#pragma unroll
                for (int bj = 0; bj < 2; ++bj) xb[ai][m][bj] = *(const u32x4*)(X + (size_t)(row0 + ai * HALF + m * 16) * 1024 + col0 + bj * HALF);
        asm volatile("" ::: "memory");
#pragma unroll
        for (int ai = 0; ai < 2; ++ai)
#pragma unroll
            for (int m = 0; m < 4; ++m) { const size_t off = (size_t)(row0 + ai * HALF + m * 16) * 1024 + col0; float ss = 0.f;
#pragma unroll
                for (int bj = 0; bj < 2; ++bj) { const u32x4 bw = xb[ai][m][bj];
                    const f32x4 v0 = unpack_lo4(bw) + acc[ai][bj][m][0], v1 = unpack_hi4(bw) + acc[ai][bj][m][1];
                    if (outf) { *(f32x4*)(outf + off + bj * HALF) = v0; *(f32x4*)(outf + off + bj * HALF + 4) = v1;
#if defined(DUP) && DUP == 60
                        asm volatile("" ::: "memory"); *(f32x4*)(outf + off + bj * HALF) = v0; *(f32x4*)(outf + off + bj * HALF + 4) = v1; asm volatile("" ::: "memory"); *(f32x4*)(outf + off + bj * HALF) = v0; *(f32x4*)(outf + off + bj * HALF + 4) = v1;
#endif
                    }
                    else { *(u32x4*)(X + off + bj * HALF) = pack8(v0, v1);
                        ss += ((v0[0] * v0[0] + v0[1] * v0[1]) + (v0[2] * v0[2] + v0[3] * v0[3])) + ((v1[0] * v1[0] + v1[1] * v1[1]) + (v1[2] * v1[2] + v1[3] * v1[3])); } }
                if (!outf) { ss += __shfl_xor(ss, 16); ss += __shfl_xor(ss, 32); if (fq == 0) P[(ai * HALF + wr * 64 + m * 16 + fr) * 4 + wc] = ss; } }
        if (!outf) {
            asm volatile("s_waitcnt lgkmcnt(0)" ::: "memory"); __builtin_amdgcn_s_barrier(); asm volatile("" ::: "memory");
            const int t = wid * 64 + lane;
            if (t < 256) { const PG8_LAS float* q = P + t * 4; rsq[(size_t)u.pn * MROWS + u.pm * BM + t] = (q[0] + q[1]) + (q[2] + q[3]); }
        }
    }
};
struct EpiRelu2 {
    static constexpr bool PERM = true, AFTER_DRAIN = false;
    bf16_t* H; const PG8_LAS float* rstab;
    __device__ __forceinline__ void operator()(const f32x4 (&acc)[2][2][4][2], const UnitV& u, int wr, int wc, int fr, int fq) const {
        const int row0 = u.pm * BM + wr * 64 + fr, col0 = u.pn * BM + wc * 32 + 8 * fq;
        float rs[2][4]; load_rstd(rstab, wr * 64 + fr, rs);
#pragma unroll
        for (int ai = 0; ai < 2; ++ai)
#pragma unroll
            for (int m = 0; m < 4; ++m) { bf16_t* rowp = H + (size_t)(row0 + ai * HALF + m * 16) * 4096 + col0;
#pragma unroll
                for (int bj = 0; bj < 2; ++bj) { f32x4 v[2];
#pragma unroll
                    for (int n = 0; n < 2; ++n) { const f32x4 x = __builtin_elementwise_max(acc[ai][bj][m][n] * rs[ai][m], (f32x4){0.f, 0.f, 0.f, 0.f}); v[n] = x * x; }
                    *(u32x4*)(rowp + bj * HALF) = pack8(v[0], v[1]); } }
    }
};

template <class Epi, class Sched, bool ALIGN_EPI = false>
__device__ __forceinline__ void gemm_phase_v(PG8_LAS unsigned char* lds, const Sched& S, const Epi& E, const int tid, const unsigned char* wsb) {
    const __amdgpu_buffer_rsrc_t srd = __builtin_amdgcn_make_buffer_rsrc((void*)wsb, (short)0, 0x7FFFFFFF, 0x00020000);
    const int wid = __builtin_amdgcn_readfirstlane(tid >> 6), lane = tid & 63, wr = wid >> 2, wc = wid & 3, fr = lane & 15, fq = lane >> 4;
    const unsigned kstep = (unsigned)(BK * 2);
    const unsigned ldsw = (unsigned)wid * 1024u;
    const int aoff = lds_byte(wr * 64 + fr, fq * 8), boff = lds_byte(wc * 32 + fr, fq * 8);
    unsigned rdA_ = (unsigned)(size_t)lds + (unsigned)aoff, rdB_ = (unsigned)(size_t)lds + 4u * HTB + (unsigned)boff; asm volatile("" : "+v"(rdA_), "+v"(rdB_));
    PG8_LAS unsigned char* const rdA = (PG8_LAS unsigned char*)(size_t)rdA_; PG8_LAS unsigned char* const rdB = (PG8_LAS unsigned char*)(size_t)rdB_;
#define PG8_SA(b, h) (((b) * 2 + (h)) * HTB)
#define PG8_SB(b, h) ((4 + (b) * 2 + (h)) * HTB)
#define PG8_STAGE(bufoff, goff, voff, hs_) do { _Pragma("unroll") for (int _i = 0; _i < 2; ++_i) \
        __builtin_amdgcn_raw_ptr_buffer_load_lds(srd, (PG8_LAS void*)(lds + (bufoff) + ldsw + _i * 8192), 16, (voff), (goff) + (unsigned)_i * ((hs_) >> 1), 0, 0); } while (0)
#define PG8_LDA(dst, b, h) do { _Pragma("unroll") for (int m = 0; m < 4; ++m) _Pragma("unroll") for (int k = 0; k < 2; ++k) dst[m][k] = *(const PG8_LAS bf16x8*)(rdA + PG8_SA(b, h) + m * 2048 + k * 1024); } while (0)
#define PG8_LDB(dst, b, h) do { _Pragma("unroll") for (int n = 0; n < 2; ++n) _Pragma("unroll") for (int k = 0; k < 2; ++k) dst[n][k] = *(const PG8_LAS bf16x8*)(rdB + (PG8_SB(b, h) - 4 * HTB) + n * 2048 + k * 1024); } while (0)
#define PG8_MMA(ai, bj, At, Bt) do { __builtin_amdgcn_s_setprio(1); _Pragma("unroll") for (int m = 0; m < 4; ++m) _Pragma("unroll") for (int n = 0; n < 2; ++n) _Pragma("unroll") for (int k = 0; k < 2; ++k) \
        acc[ai][bj][m][n] = __builtin_amdgcn_mfma_f32_16x16x32_bf16(Bt[n][k], At[m][k], acc[ai][bj][m][n], 0, 0, 0); __builtin_amdgcn_s_setprio(0); } while (0)
#define PG8_MMA0(ai, bj, At, Bt) do { __builtin_amdgcn_s_setprio(1); _Pragma("unroll") for (int m = 0; m < 4; ++m) _Pragma("unroll") for (int n = 0; n < 2; ++n) { \
        acc[ai][bj][m][n] = __builtin_amdgcn_mfma_f32_16x16x32_bf16(Bt[n][0], At[m][0], (f32x4){0.f, 0.f, 0.f, 0.f}, 0, 0, 0); \
        acc[ai][bj][m][n] = __builtin_amdgcn_mfma_f32_16x16x32_bf16(Bt[n][1], At[m][1], acc[ai][bj][m][n], 0, 0, 0); } __builtin_amdgcn_s_setprio(0); } while (0)
#define PG8_WAIT_V(n) asm volatile("s_waitcnt vmcnt(" #n ")" ::: "memory")
#define PG8_WAIT_L(n) asm volatile("s_waitcnt lgkmcnt(" #n ")" ::: "memory")
#define PG8_BAR __builtin_amdgcn_s_barrier()
#define PG8_SCHED __builtin_amdgcn_sched_barrier(0)
#define PG8_MKOFF(u_, vA_, vB_, hs_, pA_, pB_) do { const int K_ = (u_).K; int R_, C_; stage_rc(tid * 16, R_, C_); const int Rb_ = Epi::PERM ? ((R_ & ~31) + perm32(R_ & 31)) : R_; \
        vA_ = (unsigned)(R_ * K_ + C_) * 2u; vB_ = (unsigned)(Rb_ * K_ + C_) * 2u; \
        hs_ = (unsigned)(HALF * K_ * 2); pA_ = (unsigned)((const unsigned char*)(u_).A - wsb) + (unsigned)(u_).pm * (2u * hs_); pB_ = (unsigned)((const unsigned char*)(u_).Bt - wsb) + (unsigned)(u_).pn * (2u * hs_); } while (0)
    UnitV cur, nxt; int ui = 0;
    if (!S.next(0, cur)) return;
    f32x4 acc[2][2][4][2];
    bf16x8 At[4][2], B0[2][2], B1[2][2];
    unsigned vAc, vBc, vAn, vBn, hsc, hsn, cA, cB, nA, nB;
    PG8_MKOFF(cur, vAc, vBc, hsc, cA, cB);
    PG8_STAGE(PG8_SB(0, 0), cB, vBc, hsc); PG8_STAGE(PG8_SB(0, 1), cB + hsc, vBc, hsc); PG8_STAGE(PG8_SA(0, 0), cA, vAc, hsc); PG8_STAGE(PG8_SA(0, 1), cA + hsc, vAc, hsc);
    if (wr == 1) PG8_BAR;
    PG8_WAIT_V(2); PG8_BAR;
    PG8_STAGE(PG8_SB(1, 0), cB + kstep, vBc, hsc); PG8_STAGE(PG8_SA(1, 0), cA + kstep, vAc, hsc); PG8_STAGE(PG8_SB(1, 1), cB + hsc + kstep, vBc, hsc);
    PG8_WAIT_V(6); PG8_BAR;
    for (;;) {
        const bool has_next = S.next(ui + 1, nxt);
        if (!has_next) nxt = cur;
        PG8_MKOFF(nxt, vAn, vBn, hsn, nA, nB);
        const int nt = cur.K / BK;
        for (int t = 0; t < nt; t += 2) {
            const bool last = (t == nt - 2);
            const unsigned a1 = cA + (unsigned)(t + 1) * kstep;
            const unsigned a2 = last ? nA : cA + (unsigned)(t + 2) * kstep, b2 = last ? nB : cB + (unsigned)(t + 2) * kstep;
            const unsigned a3 = a2 + kstep, b3 = b2 + kstep;
            const unsigned hs2 = last ? hsn : hsc;
            const unsigned vA2 = last ? vAn : vAc, vB2 = last ? vBn : vBc;
            PG8_LDB(B0, 0, 0); PG8_LDB(B1, 0, 1); PG8_SCHED; PG8_LDA(At, 0, 0); PG8_STAGE(PG8_SA(1, 1), a1 + hsc, vAc, hsc);
            PG8_WAIT_V(8); PG8_WAIT_L(0); PG8_BAR; if (t == 0) { PG8_MMA0(0, 0, At, B0); PG8_MMA0(0, 1, At, B1); } else { PG8_MMA(0, 0, At, B0); PG8_MMA(0, 1, At, B1); } PG8_BAR; PG8_SCHED;
            PG8_LDA(At, 0, 1); PG8_STAGE(PG8_SB(0, 0), b2, vB2, hs2); PG8_STAGE(PG8_SB(0, 1), b2 + hs2, vB2, hs2); PG8_STAGE(PG8_SA(0, 0), a2, vA2, hs2);
            PG8_WAIT_V(8); PG8_WAIT_L(0); PG8_BAR; if (t == 0) { PG8_MMA0(1, 0, At, B0); PG8_MMA0(1, 1, At, B1); } else { PG8_MMA(1, 0, At, B0); PG8_MMA(1, 1, At, B1); } PG8_BAR; PG8_SCHED;
            PG8_LDB(B0, 1, 0); PG8_LDB(B1, 1, 1); PG8_SCHED; PG8_LDA(At, 1, 0); PG8_STAGE(PG8_SA(0, 1), a2 + hs2, vA2, hs2);
            PG8_WAIT_V(8); PG8_WAIT_L(0); PG8_BAR; PG8_MMA(0, 0, At, B0); PG8_MMA(0, 1, At, B1); PG8_BAR; PG8_SCHED;
            PG8_LDA(At, 1, 1); PG8_STAGE(PG8_SB(1, 0), b3, vB2, hs2); PG8_STAGE(PG8_SB(1, 1), b3 + hs2, vB2, hs2); PG8_STAGE(PG8_SA(1, 0), a3, vA2, hs2);
            PG8_WAIT_V(8); PG8_WAIT_L(0); PG8_BAR; PG8_MMA(1, 0, At, B0); PG8_MMA(1, 1, At, B1); PG8_BAR; PG8_SCHED;
        }
        if constexpr (ALIGN_EPI) { if (wr == 0) PG8_BAR; }
        if constexpr (!Epi::AFTER_DRAIN) { E(acc, cur, wr, wc, fr, fq); }
        if (!has_next) break;
        if constexpr (ALIGN_EPI && Sched::HOOK) S.unit_done(ui, wid);
        cur = nxt; cA = nA; cB = nB; hsc = hsn; vAc = vAn; vBc = vBn; ++ui;
        if constexpr (ALIGN_EPI) { if (wr == 1) PG8_BAR; }
    }
    PG8_WAIT_V(0);
    if constexpr (!ALIGN_EPI) { if (wr == 0) PG8_BAR; }
    PG8_BAR;
    if constexpr (Epi::AFTER_DRAIN) { E.fused(acc, cur, wr, wc, fr, fq, lds, wid, lane); }
#undef PG8_SA
#undef PG8_SB
#undef PG8_STAGE
#undef PG8_LDA
#undef PG8_LDB
#undef PG8_MMA
#undef PG8_MMA0
#undef PG8_WAIT_V
#undef PG8_WAIT_L
#undef PG8_BAR
#undef PG8_SCHED
#undef PG8_MKOFF
}
struct UniformSched {
    static constexpr bool HOOK = false;
    StaticOrder so; const bf16_t* A; const bf16_t* Bt; int K;
    __device__ __forceinline__ void init(const bf16_t* A_, const bf16_t* Bt_, int M, int N, int K_, int G, int c) { so.init(M, N, G, c); A = A_; Bt = Bt_; K = K_; }
    __device__ __forceinline__ bool next(int i, UnitV& u) const { Unit t; if (!so.next(i, t)) return false; u.pm = t.pm; u.pn = t.pn; u.A = A; u.Bt = Bt; u.K = K; u.tag = 0; return true; }
};
}

constexpr int NWAVES = 8, NTHREADS = NWAVES * 64;
constexpr int BATCH = 4, SEQ = 4096, D = 1024, M = BATCH * SEQ, DEPTH = 2;
constexpr int PW = 512, CW = 512, HD = 64, NH = 12, AW = 768, AO = 256, FF = 4096, INC = 7424;
constexpr int OFF_POOL = 0, OFF_CB = 512, OFF_CC = 1024, OFF_CX = 1536, OFF_Q = 2048, OFF_K = 2816, OFF_V = 3584, OFF_G = 4352;
constexpr int NZ = 4352, NG = 3072;
constexpr float RMS_EPS = 1e-6f;

constexpr size_t KiB = 1024, MiB = 1u << 20;
constexpr size_t WS_CTL = 0, CTL_ZERO_BYTES = 64 * KiB;
constexpr size_t WS_WZ = 1 * MiB;
constexpr size_t WS_WG = WS_WZ + (size_t)NZ * D * 2;
constexpr size_t WS_WPU = WS_WG + (size_t)NG * D * 2;
constexpr size_t WS_WCO = WS_WPU + (size_t)D * PW * 2;
constexpr size_t WS_WAU = WS_WCO + (size_t)D * CW * 2;
constexpr size_t WS_WO = WS_WAU + (size_t)D * AO * 2;
constexpr size_t WS_W1 = WS_WO + (size_t)D * D * 2;
constexpr size_t WS_W2 = WS_W1 + (size_t)FF * D * 2;
constexpr size_t WS_WEND = WS_W2 + (size_t)D * FF * 2;
constexpr size_t WS_XN = 36 * MiB;
constexpr size_t WS_U = 68 * MiB, WS_CB = 84 * MiB, WS_U2 = 100 * MiB, WS_Q = 116 * MiB, WS_K = 140 * MiB, WS_V = 164 * MiB;
constexpr size_t WS_H = 68 * MiB;
constexpr size_t HC_BYTES = 2 * MiB;
constexpr size_t HC_MG = 0;
constexpr size_t HC_GS = 512 * KiB;
constexpr size_t HC_YA = 1 * MiB;
constexpr size_t WS_OP = 196 * MiB;
constexpr size_t WS_LP = 220 * MiB;
constexpr size_t WS_DP = 220 * MiB + 768 * KiB;
constexpr size_t WS_YC = WS_DP + 16 * MiB;
constexpr size_t WS_END = WS_YC + 16 * MiB;
constexpr size_t WS_RSQ = WS_END;
static_assert(WS_WEND <= WS_XN && WS_RSQ + 4 * (size_t)M * 4 <= 256 * MiB && WS_V + 24 * MiB <= WS_OP && WS_H + (size_t)M * FF * 2 <= WS_OP, "d_ws map");
static_assert(M % (2 * 256 * 8) == 0, "xprep_rows2 pairs");
constexpr int CW_BAR = 4096, CW_GRP = 8192, CW_XID = 12288, CW_P1 = 12544;

constexpr int RING_OFF = 0, RING_BYTES = 131072;
constexpr int LDSCTL_OFF = RING_BYTES, MISC_OFF = LDSCTL_OFF + 320;
constexpr int BTAB_OFF = LDSCTL_OFF + 2048;
constexpr int RSTAB_OFF = LDSCTL_OFF + 1024;
constexpr int LDS_BYTES = 147456;

#define GAS __attribute__((address_space(1)))
#define LAS __attribute__((address_space(3)))
typedef unsigned short bf16;
typedef unsigned v4u __attribute__((ext_vector_type(4)));
typedef unsigned v2u __attribute__((ext_vector_type(2)));
typedef float f32x4 __attribute__((ext_vector_type(4)));
typedef float f32x16 __attribute__((ext_vector_type(16)));
typedef short bf16x8 __attribute__((ext_vector_type(8)));
typedef short s16x4 __attribute__((ext_vector_type(4)));
typedef GAS unsigned gu32;
#define RLX_AGENT __ATOMIC_RELAXED, __HIP_MEMORY_SCOPE_AGENT
#define LDS_WAIT() asm volatile("s_waitcnt lgkmcnt(0)" ::: "memory")
#define LDS_BARRIER() asm volatile("s_waitcnt lgkmcnt(0)\n\ts_barrier" ::: "memory")
#define VM_WAIT() asm volatile("s_waitcnt vmcnt(0)" ::: "memory")
__device__ __forceinline__ unsigned pk2(float lo, float hi) { return pg8::cvt_pk_bf16(lo, hi); }
__device__ __forceinline__ float bf_lo(unsigned w) { return __uint_as_float(w << 16); }
__device__ __forceinline__ float bf_hi(unsigned w) { return __uint_as_float(w & 0xffff0000u); }

#define XB_TMO      128
#define XB_XCNT(j)  (256  + 64 * (j))
#define XB_XSUB(j)  (1280 + 64 * (j))
#define XB_XGEN(j)  (2304 + 64 * (j))
#define XB_TOP      3328
#define XB_TOPGEN   3392
#define XCD_BAR_WORDS 3456
#define XB_SPIN_CAP (1u << 18)

__device__ __forceinline__ unsigned xb_ld(unsigned* p)              { return __hip_atomic_load(p, __ATOMIC_RELAXED, __HIP_MEMORY_SCOPE_AGENT); }
__device__ __forceinline__ unsigned xb_add(unsigned* p, unsigned v) { return __hip_atomic_fetch_add(p, v, __ATOMIC_RELAXED, __HIP_MEMORY_SCOPE_AGENT); }
__device__ __forceinline__ unsigned xb_xcc_id() { return (unsigned)__builtin_amdgcn_s_getreg((3 << 11) | 20) & 0xFu; }
#define XB_SPIN(cond, bar) do { unsigned _sp = 0; while (cond) { __builtin_amdgcn_s_sleep(1); \
    if ((++_sp & 255u) == 0u) { if (xb_ld(&(bar)[XB_TMO])) break; if (_sp > XB_SPIN_CAP) { atomicAdd(&(bar)[XB_TMO], 1u); break; } } } } while (0)

struct XcdBarrier {
    unsigned* bar; unsigned x; int wave;
    volatile LAS unsigned* st;
};

__device__ __forceinline__ bool xb_lane0() { unsigned o_ = ~0u; asm volatile("" : "+s"(o_)); return __builtin_amdgcn_mbcnt_hi(o_, __builtin_amdgcn_mbcnt_lo(o_, 0u)) == 0u; }
__device__ __forceinline__ XcdBarrier xcd_barrier_post(unsigned* bar, volatile LAS unsigned* st, int wave) {
    XcdBarrier b; b.bar = bar; b.x = xb_xcc_id(); b.st = st; b.wave = wave;
    if (wave == 0 && xb_lane0()) (void)xb_add(&bar[XB_XCNT(b.x)], 1u);
    return b;
}
__device__ __forceinline__ void xcd_barrier_complete(unsigned* bar, unsigned x, unsigned& nloc, unsigned& nx) {
    const unsigned G = gridDim.x * gridDim.y * gridDim.z;
    unsigned sum, cnt, mine, sp = 0u;
    for (;;) {
        sum = 0u; cnt = 0u; mine = 0u;
#pragma unroll
        for (unsigned j = 0; j < 16; ++j) { const unsigned c = xb_ld(&bar[XB_XCNT(j)]); sum += c; cnt += (c > 0u) ? 1u : 0u; mine = (j == x) ? c : mine; }
        if (sum == G) break;
        __builtin_amdgcn_s_sleep(1);
        if ((++sp & 255u) == 0u) { if (xb_ld(&bar[XB_TMO])) break; if (sp > XB_SPIN_CAP) { atomicAdd(&bar[XB_TMO], 1u); break; } }
    }
    nloc = mine > 0u ? mine : 1u; nx = cnt > 0u ? cnt : 1u;
}

template <bool FENCES = true>
__device__ __forceinline__ void xcd_barrier(const XcdBarrier& b) {
    asm volatile("s_waitcnt vmcnt(0)" ::: "memory");
    __syncthreads();
    if (b.wave == 0 && xb_lane0()) {
        unsigned* bar = b.bar;
        __builtin_amdgcn_s_waitcnt(0);
        unsigned nloc = b.st[0], nx = b.st[1];
        if (nloc == 0u) { xcd_barrier_complete(bar, b.x, nloc, nx); b.st[0] = nloc; b.st[1] = nx; }
        const unsigned old = xb_add(&bar[XB_XSUB(b.x)], 1u);
        const unsigned gen = old / nloc;
        if (old + 1u == (gen + 1u) * nloc) {
            if constexpr (FENCES) __builtin_amdgcn_fence(__ATOMIC_RELEASE, "agent");
            asm volatile("s_waitcnt vmcnt(0)" ::: "memory");
            const unsigned og = xb_add(&bar[XB_TOP], 1u);
            const unsigned tg = og / nx;
            if constexpr (FENCES) __builtin_amdgcn_fence(__ATOMIC_ACQUIRE, "agent");
            if (og + 1u == (tg + 1u) * nx) xb_add(&bar[XB_TOPGEN], 1u);
            else XB_SPIN(xb_ld(&bar[XB_TOPGEN]) == tg, bar);
            xb_add(&bar[XB_XGEN(b.x)], 1u);
            asm volatile("s_waitcnt vmcnt(0)" ::: "memory");
        } else {
            if constexpr (FENCES) __builtin_amdgcn_fence(__ATOMIC_ACQUIRE, "agent");
            XB_SPIN(xb_ld(&bar[XB_XGEN(b.x)]) == gen, bar);
            asm volatile("s_waitcnt vmcnt(0)" ::: "memory");
        }
    }
    __syncthreads();
}

__device__ __forceinline__ void group_barrier(const XcdBarrier& b, unsigned* cnt, unsigned target, unsigned* ids) {
    asm volatile("s_waitcnt vmcnt(0)" ::: "memory");
    __syncthreads();
    if (b.wave == 0 && xb_lane0()) {
        __builtin_amdgcn_s_waitcnt(0);
        unsigned same = b.st[2];
        if (same == 0u) { same = 1u;
#pragma unroll
            for (int j = 0; j < 4; ++j) same = (xb_ld(&ids[64 * j]) == b.x + 1u) ? same : 2u;
            b.st[2] = same; }
        if (same != 1u) { __builtin_amdgcn_fence(__ATOMIC_RELEASE, "agent"); asm volatile("s_waitcnt vmcnt(0)" ::: "memory"); }
        (void)xb_add(cnt, 1u);
        __builtin_amdgcn_fence(__ATOMIC_ACQUIRE, "agent");
        XB_SPIN(xb_ld(cnt) < target, b.bar);
        asm volatile("s_waitcnt vmcnt(0)" ::: "memory");
    }
    __syncthreads();
}

__device__ __forceinline__ void split_arrive(const XcdBarrier& b, int wave, unsigned* base, unsigned round) {
    asm volatile("s_waitcnt vmcnt(0)" ::: "memory");
    __builtin_amdgcn_s_barrier();
    if (wave == 0 && xb_lane0()) {
        __builtin_amdgcn_s_waitcnt(0);
        const unsigned nloc = b.st[0];
        const unsigned old = xb_add(&base[64 * b.x], 1u);
        if (old + 1u == round * nloc) {
            __builtin_amdgcn_fence(__ATOMIC_RELEASE, "agent");
            asm volatile("s_waitcnt vmcnt(0)" ::: "memory");
            (void)xb_add(&base[64 * 16], 1u);
        }
    }
}
__device__ __forceinline__ void split_wait(const XcdBarrier& b, int wave, unsigned* base, unsigned round) {
    if (wave == 0 && xb_lane0()) {
        const unsigned nx = b.st[1];
        __builtin_amdgcn_fence(__ATOMIC_ACQUIRE, "agent");
        XB_SPIN(xb_ld(&base[64 * 16]) < round * nx, b.bar);
        asm volatile("s_waitcnt vmcnt(0)" ::: "memory");
    }
    __syncthreads();
}


#ifndef ALIGN_MULTI
#define ALIGN_MULTI true
#endif
#ifndef DUP
#define DUP -1
#endif
#define REPS(k) for (int rep_ = 0; rep_ < ((DUP == (k)) ? 2 : 1); ++rep_)
struct Frame {
    LAS unsigned char* lds;
    volatile LAS unsigned* MISC;
    gu32* ctl;
    int tid, lane, wave;
    int vcu, G;
    unsigned char* ws;
};

__device__ __forceinline__ float wave_sum(float v) {
#pragma unroll
    for (int o = 1; o < 64; o <<= 1) v += __shfl_xor(v, o);
    return v;
}
__device__ __forceinline__ float wave_max(float v) {
#pragma unroll
    for (int o = 1; o < 64; o <<= 1) v = fmaxf(v, __shfl_xor(v, o));
    return v;
}

__device__ __forceinline__ void transpose_item(const float* W, int ldw, int k0, int srccol0, bf16* WT, int K, int destrow0, LAS float* scr, int lane, const float* gain = nullptr) {
    const int kr = lane >> 3, c4 = (lane & 7) * 4;
    f32x4 v[8];
#pragma unroll
    for (int i = 0; i < 8; ++i) v[i] = __builtin_nontemporal_load((const GAS f32x4*)(W + (size_t)(k0 + 8 * i + kr) * ldw + srccol0 + c4));
    if (gain) {
#pragma unroll
        for (int i = 0; i < 8; ++i) v[i] = v[i] * gain[k0 + 8 * i + kr]; }
#pragma unroll
    for (int i = 0; i < 8; ++i) { LAS float* d = scr + (8 * i + kr) * 33 + c4; d[0] = v[i].x; d[1] = v[i].y; d[2] = v[i].z; d[3] = v[i].w; }
    LDS_WAIT(); asm volatile("" ::: "memory");
    const int c = lane & 7;
#pragma unroll
    for (int j = 0; j < 4; ++j) { const int n = (lane >> 3) + 8 * j; const LAS float* s = scr + (8 * c) * 33 + n;
        v4u o; o.x = pk2(s[0 * 33], s[1 * 33]); o.y = pk2(s[2 * 33], s[3 * 33]); o.z = pk2(s[4 * 33], s[5 * 33]); o.w = pk2(s[6 * 33], s[7 * 33]);
        *(GAS v4u*)(WT + (size_t)(destrow0 + n) * K + k0 + 8 * c) = o; }
    LDS_WAIT(); asm volatile("" ::: "memory");
}
__device__ __forceinline__ int wz_src_col(int rb) {
    const int tile = rb >> 3, pb = rb & 7;
    if (tile < 4) return tile * 256 + pb * 32;
    if (tile < 8) return ((pb >> 2) ? OFF_CX : OFF_CC) + (tile - 4) * 128 + (pb & 3) * 32;
    if (tile < 14) { const int wc = pb & 3, bj = pb >> 2; return OFF_Q + (tile - 8) * 256 + 64 * wc + 32 * bj; }
    return OFF_V + (tile - 14) * 256 + pb * 32;
}
__device__ __forceinline__ void xprep_rows2(const float* x, bf16* xo, float* rsq, int row0, int row1, int lane) {
    const GAS f32x4* xa = (const GAS f32x4*)(x + (size_t)row0 * D) + lane; const GAS f32x4* xb = (const GAS f32x4*)(x + (size_t)row1 * D) + lane;
    f32x4 va[4], vb[4];
#pragma unroll
    for (int j = 0; j < 4; ++j) { va[j] = __builtin_nontemporal_load(xa + 64 * j); vb[j] = __builtin_nontemporal_load(xb + 64 * j); }
    float sa = 0.f, sb = 0.f;
#pragma unroll
    for (int j = 0; j < 4; ++j) { sa += (va[j].x * va[j].x + va[j].y * va[j].y) + (va[j].z * va[j].z + va[j].w * va[j].w); sb += (vb[j].x * vb[j].x + vb[j].y * vb[j].y) + (vb[j].z * vb[j].z + vb[j].w * vb[j].w); }
    sa = wave_sum(sa); sb = wave_sum(sb);
    GAS unsigned long long* oa = (GAS unsigned long long*)(xo + (size_t)row0 * D) + lane; GAS unsigned long long* ob = (GAS unsigned long long*)(xo + (size_t)row1 * D) + lane;
#pragma unroll
    for (int j = 0; j < 4; ++j) { oa[64 * j] = (unsigned long long)pk2(va[j].x, va[j].y) | ((unsigned long long)pk2(va[j].z, va[j].w) << 32);
                                  ob[64 * j] = (unsigned long long)pk2(vb[j].x, vb[j].y) | ((unsigned long long)pk2(vb[j].z, vb[j].w) << 32); }
    if (lane < 4) { rsq[(size_t)lane * M + row0] = (lane == 0) ? sa : 0.f; rsq[(size_t)lane * M + row1] = (lane == 0) ? sb : 0.f; }
}

struct LayerW {
    const float *norm_mix, *w_in, *b_gate, *pool_mix, *pool_scale, *conv_w, *q_gain, *k_gain, *w_pool_up, *w_conv_out, *w_attn_up, *w_o, *norm_mlp, *w_ff1, *w_ff2;
};

__device__ __forceinline__ void convert_weights(Frame& F, const LayerW& L, int part, int gw, int NGW) {
    LAS float* scr = (LAS float*)(F.lds + RING_OFF + F.wave * 16384);
    unsigned char* ws = F.ws;
    constexpr int I_WZ = (NZ / 32) * (D / 64), I_WG = (NG / 32) * (D / 64), I_CO = (D / 32) * (CW / 64), I_AU = (D / 32) * (AO / 64), I_WO = (D / 32) * (D / 64), I_W1 = (FF / 32) * (D / 64), I_W2 = (D / 32) * (FF / 64);
    if (part == 0) {
        for (int r = gw; r < I_WZ; r += NGW) { const int rb = r / (D / 64), kb = r % (D / 64); transpose_item(L.w_in, INC, kb * 64, wz_src_col(rb), (bf16*)(ws + WS_WZ), D, rb * 32, scr, F.lane, L.norm_mix); }
        return;
    }
    constexpr int NITEMS = I_WG + I_CO + I_AU + I_WO + I_W1 + I_W2;
    for (int it = gw; it < NITEMS; it += NGW) {
        int r = it;
        if (r < I_WG) { const int rb = r / (D / 64), kb = r % (D / 64); transpose_item(L.w_in, INC, kb * 64, OFF_G + rb * 32, (bf16*)(ws + WS_WG), D, rb * 32, scr, F.lane, L.norm_mix); continue; } r -= I_WG;
        if (r < I_CO) { const int rb = r / (CW / 64), kb = r % (CW / 64); transpose_item(L.w_conv_out, D, kb * 64, rb * 32, (bf16*)(ws + WS_WCO), CW, rb * 32, scr, F.lane); continue; } r -= I_CO;
        if (r < I_AU) { const int rb = r / (AO / 64), kb = r % (AO / 64); transpose_item(L.w_attn_up, D, kb * 64, rb * 32, (bf16*)(ws + WS_WAU), AO, rb * 32, scr, F.lane); continue; } r -= I_AU;
        if (r < I_WO) { const int rb = r / (D / 64), kb = r % (D / 64); transpose_item(L.w_o, D, kb * 64, rb * 32, (bf16*)(ws + WS_WO), D, rb * 32, scr, F.lane); continue; } r -= I_WO;
        if (r < I_W1) { const int rb = r / (D / 64), kb = r % (D / 64); transpose_item(L.w_ff1, FF, kb * 64, rb * 32, (bf16*)(ws + WS_W1), D, rb * 32, scr, F.lane, L.norm_mlp); continue; } r -= I_W1;
        { const int rb = r / (FF / 64), kb = r % (FF / 64); transpose_item(L.w_ff2, D, kb * 64, rb * 32, (bf16*)(ws + WS_W2), FF, rb * 32, scr, F.lane); }
    }
    for (int grp = gw >> 3; grp < (PW / 64) * (D / 32); grp += NGW >> 3) {
        const int kb = (grp / (D / 32)) * 8 + F.wave, nb = grp % (D / 32), k0 = kb * 8, g = k0 >> 7, n = nb * 32 + (F.lane & 31), dh = (F.lane >> 5) * 64;
        float a[8];
#pragma unroll
        for (int i = 0; i < 8; ++i) a[i] = 0.f;
        const float* mixr = L.pool_mix + (size_t)g * 128 * 128 + (size_t)(k0 & 127) * 128 + dh;
        const float* wp = L.w_pool_up + (size_t)(g * 128 + dh) * D + n; const float* sp = L.pool_scale + g * 128 + dh;
#pragma unroll 8
        for (int d = 0; d < 64; ++d) {
            const float wv = wp[(size_t)d * D] * sp[d];
#pragma unroll
            for (int i = 0; i < 8; ++i) a[i] += mixr[i * 128 + d] * wv;
        }
#pragma unroll
        for (int i = 0; i < 8; ++i) a[i] += __shfl_xor(a[i], 32);
        if (F.lane < 32) { v4u o; o.x = pk2(a[0], a[1]); o.y = pk2(a[2], a[3]); o.z = pk2(a[4], a[5]); o.w = pk2(a[6], a[7]);
            *(GAS v4u*)((bf16*)(ws + WS_WPU) + (size_t)n * PW + k0) = o; }
    }
}

template <int W> __device__ __forceinline__ void pool_run(const bf16* U, bf16* DP, int g, int run, int lane) {
    const int b = run >> 7, t0 = (run & 127) * 32; const size_t rowb = (size_t)b * SEQ;
    const int c = g * 128 + 2 * lane;
    unsigned w[32 + W];
#pragma unroll
    for (int k = 0; k < 32 + W; ++k) { const int tt = t0 - W + k; w[k] = (tt >= 0) ? *(const GAS unsigned*)(U + (rowb + tt) * PW + c) : 0u; }
    float s0 = 0.f, s1 = 0.f;
#pragma unroll
    for (int k = 0; k < W; ++k) { s0 += bf_lo(w[k]); s1 += bf_hi(w[k]); }
#pragma unroll
    for (int k = 0; k < 32; ++k) { const int t = t0 + k; const float n0 = bf_lo(w[W + k]), n1 = bf_hi(w[W + k]);
        s0 += n0 - bf_lo(w[k]); s1 += n1 - bf_hi(w[k]);
        const float inv = 1.0f / (float)((t + 1 < W) ? t + 1 : W);
        *(GAS unsigned*)(DP + (rowb + t) * PW + c) = pk2(s0 * inv - n0, s1 * inv - n1); }
}
__device__ __forceinline__ void conv_run(const bf16* U2, const bf16* CBp, const float* cw, bf16* YC, int run, int lane) {
    const int b = run >> 9, t0 = (run & 511) * 8; const size_t rowb = (size_t)b * SEQ; const int c = 8 * lane;
    v4u uw[10], bw[8];
    const int tw = t0 >= 2 ? t0 - 2 : 0;
    uw[0] = *(const GAS v4u*)(U2 + (rowb + tw) * CW + c); uw[1] = *(const GAS v4u*)(U2 + (rowb + tw + 1) * CW + c);
#pragma unroll
    for (int k = 0; k < 8; ++k) { uw[k + 2] = *(const GAS v4u*)(U2 + (rowb + t0 + k) * CW + c); bw[k] = *(const GAS v4u*)(CBp + (rowb + t0 + k) * CW + c); }
    float w0[8], w1[8], w2[8];
#pragma unroll
    for (int e = 0; e < 8; ++e) { w0[e] = cw[c + e]; w1[e] = cw[CW + c + e]; w2[e] = cw[2 * CW + c + e]; }
    asm volatile("" ::: "memory");
    if (t0 < 2) { uw[0] = (v4u){0u, 0u, 0u, 0u}; uw[1] = (v4u){0u, 0u, 0u, 0u}; }
#define CV_UNPK(q_, f_) do { const v4u t_ = (q_); f_[0] = bf_lo(t_.x); f_[1] = bf_hi(t_.x); f_[2] = bf_lo(t_.y); f_[3] = bf_hi(t_.y); f_[4] = bf_lo(t_.z); f_[5] = bf_hi(t_.z); f_[6] = bf_lo(t_.w); f_[7] = bf_hi(t_.w); } while (0)
#pragma unroll
    for (int k = 0; k < 8; ++k) { float p2[8], p1[8], u[8], bg[8], y[8];
        CV_UNPK(uw[k], p2); CV_UNPK(uw[k + 1], p1); CV_UNPK(uw[k + 2], u); CV_UNPK(bw[k], bg);
#pragma unroll
        for (int e = 0; e < 8; ++e) y[e] = bg[e] * (w2[e] * u[e] + w1[e] * p1[e] + w0[e] * p2[e]);
        v4u o; o.x = pk2(y[0], y[1]); o.y = pk2(y[2], y[3]); o.z = pk2(y[4], y[5]); o.w = pk2(y[6], y[7]);
        *(GAS v4u*)(YC + (rowb + t0 + k) * CW + c) = o; }
#undef CV_UNPK
}

constexpr int KPITCH = 144;
static_assert(384 * (192 + 144) <= RING_BYTES, "attention tiles");
constexpr int VPITCH = 192;
__device__ __forceinline__ int crow(int r, int hi) { return (r & 3) + 8 * (r >> 2) + 4 * hi; }
struct AttnCoord { int b, h, g, dil, rr, i0; };
__device__ __forceinline__ AttnCoord attn_decode(int unit) {
    AttnCoord c; c.b = unit / 192; const int rem = unit % 192; c.h = rem >> 4; const int s = rem & 15; c.g = c.h >> 2; const int lg = 2 * c.g; c.dil = 1 << lg;
    const int nub = 16 >> lg; c.rr = s / nub; c.i0 = (s % nub) * 256; return c;
}
__device__ __forceinline__ void attn_issue(const Frame& F, const AttnCoord& c, v4u (&vv)[6], v4u (&kk)[6], bf16x8 (&qn)[4]) {
    const bf16* Q = (const bf16*)(F.ws + WS_Q); const bf16* K = (const bf16*)(F.ws + WS_K); const bf16* V = (const bf16*)(F.ws + WS_V);
    const size_t rowb = (size_t)c.b * SEQ; const int tid = F.tid, r32 = F.lane & 31, hi = F.lane >> 5;
#pragma unroll
    for (int ps = 0; ps < 6; ++ps) { const int kl = ps * 64 + (tid >> 3), ch = tid & 7, ip = c.i0 - 128 + kl, ipc = ip < 0 ? 0 : ip;
        vv[ps] = *(const GAS v4u*)(V + (rowb + (size_t)ipc * c.dil + c.rr) * AW + c.h * HD + ch * 8);
        kk[ps] = *(const GAS v4u*)(K + (rowb + (size_t)ipc * c.dil + c.rr) * AW + c.h * HD + ch * 8); }
    const int iq = c.i0 + 32 * F.wave + r32;
    const bf16* qp = Q + (rowb + (size_t)iq * c.dil + c.rr) * AW + c.h * HD + 8 * hi;
#pragma unroll
    for (int d0 = 0; d0 < 4; ++d0) qn[d0] = *(const GAS bf16x8*)(qp + 16 * d0);
}
__device__ __forceinline__ void attn_units(Frame& F, int u0, int du, int nu, float Cc) {
    bf16* OP = (bf16*)(F.ws + WS_OP); float* LP = (float*)(F.ws + WS_LP);
    LAS unsigned char* Vs = F.lds + RING_OFF; LAS unsigned char* Ks = Vs + 384 * VPITCH;
    const int tid = F.tid, lane = F.lane, w = F.wave, r32 = lane & 31, hi = lane >> 5;
    v4u vv[6], kk[6]; bf16x8 qn[4];
    if (u0 < nu) attn_issue(F, attn_decode(u0), vv, kk, qn);
#pragma unroll 1
  for (int unit = u0; unit < nu; unit += du) {
    const AttnCoord c = attn_decode(unit);
    const int h = c.h, g = c.g, dil = c.dil, rr = c.rr, i0 = c.i0;
    const size_t rowb = (size_t)c.b * SEQ;
#pragma unroll
    for (int ps = 0; ps < 6; ++ps) { const int kl = ps * 64 + (tid >> 3), ch = tid & 7, ip = i0 - 128 + kl;
        v4u v = vv[ps]; if (ip < 0) v = (v4u){0u, 0u, 0u, 0u};
        *(LAS v4u*)(Vs + kl * VPITCH + ch * 16) = v;
        *(LAS v4u*)(Ks + kl * KPITCH + ch * 16) = kk[ps]; }
    const int iq = i0 + 32 * w + r32;
    bf16x8 qf[4];
#pragma unroll
    for (int d0 = 0; d0 < 4; ++d0) qf[d0] = qn[d0];
    LDS_BARRIER();
    if (unit + du < nu) attn_issue(F, attn_decode(unit + du), vv, kk, qn);
    const LAS unsigned char* kb = Ks + (32 * w + r32) * KPITCH + 16 * hi;
    bf16x8 kfn[4];
#pragma unroll
    for (int d0 = 0; d0 < 4; ++d0) kfn[d0] = *(const LAS bf16x8*)(kb + 32 * d0);
    f32x16 o0 = {}, o1 = {}; float lsum = 0.f;
    const int t4 = r32 - 4 * hi;
    const int trb = (4 * hi + ((lane & 15) >> 2)) * VPITCH + (16 * ((lane >> 4) & 1) + 4 * (lane & 3)) * 2;
#pragma unroll 1
    for (int kt = 0; kt < 5; ++kt) {
        const int kl0 = 32 * w + 32 * kt, ipb = i0 - 128 + kl0;
        bf16x8 kf[4];
#pragma unroll
        for (int d0 = 0; d0 < 4; ++d0) kf[d0] = kfn[d0];
        {
            const int ktn = kt < 4 ? kt + 1 : 4;
#pragma unroll
            for (int d0 = 0; d0 < 4; ++d0) kfn[d0] = *(const LAS bf16x8*)(kb + 32 * ktn * KPITCH + 32 * d0);
        }
        f32x16 sacc = {};
#pragma unroll
        for (int d0 = 0; d0 < 4; ++d0) sacc = __builtin_amdgcn_mfma_f32_32x32x16_bf16(kf[d0], qf[d0], sacc, 0, 0, 0);
        LAS unsigned char* vb = Vs + kl0 * VPITCH + trb;
        bf16x8 vf[4];
#pragma unroll
        for (int db = 0; db < 2; ++db)
#pragma unroll
            for (int st = 0; st < 2; ++st) {
                const s16x4 lo = __builtin_bit_cast(s16x4, __builtin_amdgcn_ds_read_tr16_b64_v4i16((LAS s16x4*)(vb + (16 * st) * VPITCH + db * 64)));
                const s16x4 hi4 = __builtin_bit_cast(s16x4, __builtin_amdgcn_ds_read_tr16_b64_v4i16((LAS s16x4*)(vb + (16 * st + 8) * VPITCH + db * 64)));
                vf[db * 2 + st] = (bf16x8){lo[0], lo[1], lo[2], lo[3], hi4[0], hi4[1], hi4[2], hi4[3]};
            }
        __builtin_amdgcn_sched_barrier(0);
        float p[16];
        if (ipb < 0) {
#pragma unroll
            for (int r = 0; r < 16; ++r) p[r] = 0.f;
        } else if (kt == 0) {
#pragma unroll
            for (int r = 0; r < 16; ++r) { p[r] = (t4 <= (r & 3) + 8 * (r >> 2)) ? __builtin_amdgcn_exp2f(sacc[r] - Cc) : 0.f; lsum += p[r]; }
        } else if (kt == 4) {
#pragma unroll
            for (int r = 0; r < 16; ++r) { p[r] = ((r & 3) + 8 * (r >> 2) <= t4) ? __builtin_amdgcn_exp2f(sacc[r] - Cc) : 0.f; lsum += p[r]; }
        } else {
#pragma unroll
            for (int r = 0; r < 16; ++r) { p[r] = __builtin_amdgcn_exp2f(sacc[r] - Cc); lsum += p[r]; }
        }
        v4u pb0, pb1;
        pb0.x = pk2(p[0], p[1]); pb0.y = pk2(p[2], p[3]); pb0.z = pk2(p[4], p[5]); pb0.w = pk2(p[6], p[7]);
        pb1.x = pk2(p[8], p[9]); pb1.y = pk2(p[10], p[11]); pb1.z = pk2(p[12], p[13]); pb1.w = pk2(p[14], p[15]);
        const bf16x8 pf0 = __builtin_bit_cast(bf16x8, pb0), pf1 = __builtin_bit_cast(bf16x8, pb1);
        asm volatile("" : "+v"(vf[0]), "+v"(vf[1]), "+v"(vf[2]), "+v"(vf[3]));
        o0 = __builtin_amdgcn_mfma_f32_32x32x16_bf16(vf[0], pf0, o0, 0, 0, 0);
        o0 = __builtin_amdgcn_mfma_f32_32x32x16_bf16(vf[1], pf1, o0, 0, 0, 0);
        o1 = __builtin_amdgcn_mfma_f32_32x32x16_bf16(vf[2], pf0, o1, 0, 0, 0);
        o1 = __builtin_amdgcn_mfma_f32_32x32x16_bf16(vf[3], pf1, o1, 0, 0, 0);
    }
    lsum += __shfl_xor(lsum, 32);
    const size_t orow = rowb + (size_t)iq * dil + rr;
    bf16* op = OP + ((size_t)g * M + orow) * AO + (h & 3) * HD;
#pragma unroll
    for (int pr = 0; pr < 4; ++pr) {
        const int ra = 2 * (pr & 1), rb = ra + 1;
        unsigned ax, ay, bx, by;
        if (pr < 2) { ax = pk2(o0[4 * ra], o0[4 * ra + 1]); ay = pk2(o0[4 * ra + 2], o0[4 * ra + 3]); bx = pk2(o0[4 * rb], o0[4 * rb + 1]); by = pk2(o0[4 * rb + 2], o0[4 * rb + 3]); }
        else        { ax = pk2(o1[4 * ra], o1[4 * ra + 1]); ay = pk2(o1[4 * ra + 2], o1[4 * ra + 3]); bx = pk2(o1[4 * rb], o1[4 * rb + 1]); by = pk2(o1[4 * rb + 2], o1[4 * rb + 3]); }
        { const auto r = __builtin_amdgcn_permlane32_swap(ax, bx, false, false); ax = r[0]; bx = r[1]; }
        { const auto r = __builtin_amdgcn_permlane32_swap(ay, by, false, false); ay = r[0]; by = r[1]; }
        v4u o; o.x = ax; o.y = ay; o.z = bx; o.w = by;
        *(GAS v4u*)(op + (pr < 2 ? 0 : 32) + 8 * ra + 8 * hi) = o; }
    if (hi == 0) LP[((size_t)g * M + orow) * 4 + (h & 3)] = lsum;
    LDS_BARRIER();
  }
}
__device__ __forceinline__ void combine_panel(Frame& F, int pm) {
    const bf16* OP = (const bf16*)(F.ws + WS_OP); const float* LP = (const float*)(F.ws + WS_LP); bf16* YA = (bf16*)(F.ws + WS_H + HC_YA + (size_t)pm * (HC_BYTES - 256 * AO * 2));
#pragma unroll 1
    for (int it0 = F.tid; it0 < 256 * 32; it0 += 4 * NTHREADS) {
        v4u w[4][3]; float lp[4][3];
#pragma unroll
        for (int q = 0; q < 4; ++q) { const int it = it0 + q * NTHREADS, m = pm * 256 + (it >> 5), ch = it & 31, j = ch >> 3;
#pragma unroll
            for (int g = 0; g < 3; ++g) { w[q][g] = *(const GAS v4u*)(OP + ((size_t)g * M + m) * AO + ch * 8); lp[q][g] = LP[((size_t)g * M + m) * 4 + j]; } }
        asm volatile("" ::: "memory");
#pragma unroll
        for (int q = 0; q < 4; ++q) { const int it = it0 + q * NTHREADS, m = pm * 256 + (it >> 5), ch = it & 31;
            float acc[8];
#pragma unroll
            for (int e = 0; e < 8; ++e) acc[e] = 0.f;
#pragma unroll
            for (int g = 0; g < 3; ++g) { const v4u x = w[q][g];
                acc[0] += bf_lo(x.x); acc[1] += bf_hi(x.x); acc[2] += bf_lo(x.y); acc[3] += bf_hi(x.y); acc[4] += bf_lo(x.z); acc[5] += bf_hi(x.z); acc[6] += bf_lo(x.w); acc[7] += bf_hi(x.w); }
            const float inv = 1.0f / ((lp[q][0] + lp[q][1]) + lp[q][2]);
            v4u o; o.x = pk2(acc[0] * inv, acc[1] * inv); o.y = pk2(acc[2] * inv, acc[3] * inv); o.z = pk2(acc[4] * inv, acc[5] * inv); o.w = pk2(acc[6] * inv, acc[7] * inv);
            *(GAS v4u*)(YA + (size_t)m * AO + ch * 8) = o; }
    }
}
__device__ __forceinline__ void rstd_panel_to_lds(Frame& F, int pm) {
    if (F.tid < 256) { const float* rsq = (const float*)(F.ws + WS_RSQ) + pm * 256 + F.tid;
        const float s4 = (rsq[0] + rsq[M]) + (rsq[2 * M] + rsq[3 * M]);
        ((LAS float*)(F.lds + RSTAB_OFF))[F.tid] = __builtin_amdgcn_rsqf(s4 * (1.0f / D) + RMS_EPS); }
    LDS_WAIT(); __syncthreads();
}
__device__ __forceinline__ void my_panel(int c, int& pm, int& q) { pm = 8 * (c & 7) + ((c >> 3) & 7); q = c >> 6; }
struct P1Sched {
    static constexpr bool HOOK = true;
    int pm, q; const bf16* A; const bf16* Bt; XcdBarrier xb; unsigned* base; unsigned round;
    __device__ __forceinline__ void unit_done(int ui, int wave) const { if (ui == 3) split_arrive(xb, wave, base, round); }
    __device__ __forceinline__ bool next(int i, pg8::UnitV& u) const {
        const int pn = q + 4 * i; if (pn >= NZ / 256) return false;
        int pm_ = pm; asm volatile("" : "+s"(pm_));
        u.pm = pm_; u.pn = pn; u.A = A; u.Bt = Bt; u.K = D; u.tag = 0; return true;
    }
};
struct P34Sched {
    static constexpr bool HOOK = false;
    int pm, pn; unsigned char* ws;
    __device__ __forceinline__ bool next(int i, pg8::UnitV& u) const {
        if (i >= ((DUP == 51) ? 7 : 6)) return false;
        if (i == 6) i = 4;
        const int br = i >> 1; int pm_ = pm, pn_ = pn; asm volatile("" : "+s"(pm_), "+s"(pn_));
        u.pm = pm_;
        if (!(i & 1)) { u.pn = 4 * br + pn_; u.A = (const bf16*)(ws + WS_XN); u.Bt = (const bf16*)(ws + WS_WG); u.K = D; u.tag = 2 * br + 1; }
        else { const size_t oa = (br == 0) ? WS_DP : (br == 1) ? WS_YC : WS_H + HC_YA + (size_t)pm_ * (HC_BYTES - 256 * AO * 2), ob = (br == 0) ? WS_WPU : (br == 1) ? WS_WCO : WS_WAU;
               u.pn = pn_; u.A = (const bf16*)(ws + oa); u.Bt = (const bf16*)(ws + ob); u.K = (br == 2) ? AO : PW; u.tag = 2 * br; }
        return true;
    }
};

struct Args { const float* in[16]; float* out; unsigned char* ws; };
#define PHASE_BEGIN() Frame F = F0; int lq = l; { int w_ = F0.wave; asm volatile("" : "+s"(w_)); unsigned o_ = ~0u; asm volatile("" : "+s"(o_)); int t_ = w_ * 64 + (int)__builtin_amdgcn_mbcnt_hi(o_, __builtin_amdgcn_mbcnt_lo(o_, 0u)); asm volatile("" : "+v"(t_)); asm volatile("" : "+s"(lq)); F.tid = t_; F.lane = t_ & 63; F.wave = __builtin_amdgcn_readfirstlane(t_ >> 6); } \
    unsigned char* const ws = F.ws; const int gw = F.vcu * NWAVES + F.wave, NGW = F.G * NWAVES; (void)gw; (void)NGW; (void)ws
#define LIN(k, stride) (args.in[k] + (size_t)lq * (stride))
__global__ void __launch_bounds__(NTHREADS, 2) mega_fwd(Args args) {
    extern __shared__ __attribute__((aligned(16))) unsigned char lds[];
    Frame F0;
    F0.lds = (LAS unsigned char*)lds;
    F0.MISC = (volatile LAS unsigned*)(F0.lds + MISC_OFF);
    F0.tid = threadIdx.x; F0.lane = F0.tid & 63; F0.wave = __builtin_amdgcn_readfirstlane(F0.tid >> 6);
    F0.G = gridDim.x; { const int bx = blockIdx.x; F0.vcu = (F0.G % 8 == 0) ? (bx % 8) * (F0.G / 8) + bx / 8 : bx; }
    F0.ws = args.ws; F0.ctl = (gu32*)(args.ws + WS_CTL);
    for (int u = F0.tid; u < (LDS_BYTES - LDSCTL_OFF) / 4; u += NTHREADS) ((LAS unsigned*)(F0.lds + LDSCTL_OFF))[u] = 0u;
    __syncthreads();
    unsigned* const bar_base = (unsigned*)(F0.ctl + CW_BAR);
    XcdBarrier bar = xcd_barrier_post(bar_base, F0.MISC + 8, F0.wave);
    if (F0.wave == 0 && xb_lane0()) (void)xb_add((unsigned*)(F0.ctl + CW_XID) + blockIdx.x, bar.x + 1u);
#define GRID_BAR() do { int w_ = F0.wave; unsigned o_ = CW_BAR; asm volatile("" : "+s"(w_), "+s"(o_)); bar.wave = w_; bar.bar = (unsigned*)(F0.ctl + o_); xcd_barrier(bar); } while (0)
#define EXEC_BAR() do { int w_ = F0.wave; unsigned o_ = CW_BAR; asm volatile("" : "+s"(w_), "+s"(o_)); bar.wave = w_; bar.bar = (unsigned*)(F0.ctl + o_); xcd_barrier<false>(bar); } while (0)
#define GROUP_BAR(n) do { int w_ = F0.wave; unsigned o_ = 0u; asm volatile("" : "+s"(w_), "+s"(o_)); bar.wave = w_; unsigned* const cb_ = (unsigned*)(F0.ctl + o_); bar.bar = cb_ + CW_BAR; \
        group_barrier(bar, cb_ + CW_GRP + 64 * ((int)blockIdx.x & 63), 4u * (unsigned)(n), cb_ + CW_XID + ((int)blockIdx.x & 63)); } while (0)

#pragma unroll 1
    for (int l = 0; l < DEPTH; ++l) {
#define LAYERW(L) LayerW L; L.norm_mix = LIN(1, D); L.w_in = LIN(2, (size_t)D * INC); L.pool_mix = LIN(4, 4 * 128 * 128); L.pool_scale = LIN(5, PW); \
            L.w_pool_up = LIN(9, (size_t)PW * D); L.w_conv_out = LIN(10, (size_t)CW * D); L.w_attn_up = LIN(11, (size_t)AO * D); L.w_o = LIN(12, (size_t)D * D); \
            L.w_ff1 = LIN(14, (size_t)D * FF); L.w_ff2 = LIN(15, (size_t)FF * D); L.norm_mlp = LIN(13, D)
        REPS(0) {
            PHASE_BEGIN();
            LAYERW(L);
            convert_weights(F, L, 0, gw, NGW);
#ifdef CONV_IN_P0
            convert_weights(F, L, 1, gw, NGW);
#endif
            if (lq == 0) for (int m = gw; m < M; m += 2 * NGW) xprep_rows2(args.in[0], (bf16*)(ws + WS_XN), (float*)(ws + WS_RSQ), m, m + NGW, F.lane);
        }
        GRID_BAR();

        REPS(1) {
            PHASE_BEGIN();
            int pm0, q0; my_panel((int)blockIdx.x, pm0, q0);
            rstd_panel_to_lds(F, pm0);
            unsigned o1_ = CW_P1; asm volatile("" : "+s"(o1_)); unsigned* const p1b = (unsigned*)(F0.ctl + o1_);
            P1Sched S{pm0, q0, (const bf16*)(ws + WS_XN), (const bf16*)(ws + WS_WZ), bar, p1b, (unsigned)lq + 1u};
            pg8::EpiZ E{(bf16*)(ws + WS_U), (bf16*)(ws + WS_CB), (bf16*)(ws + WS_U2), (bf16*)(ws + WS_Q), (bf16*)(ws + WS_K), (bf16*)(ws + WS_V), LIN(7, HD), LIN(8, HD), (const LAS float*)(F.lds + RSTAB_OFF)};
            pg8::gemm_phase_v<pg8::EpiZ, P1Sched, ALIGN_MULTI>(F.lds + RING_OFF, S, E, F.tid, ws);
            if (q0 != 0) {
                split_arrive(bar, F.wave, p1b, (unsigned)lq + 1u); split_wait(bar, F.wave, p1b, (unsigned)lq + 1u);
                const int gw2 = ((q0 - 1) * 64 + ((int)blockIdx.x & 63)) * NWAVES + F.wave, NGW2 = 192 * NWAVES;
                for (int it = gw2; it < 2048; it += NGW2) { const int g = it & 3, run = it >> 2; const bf16* U = (const bf16*)(ws + WS_U); bf16* DP = (bf16*)(ws + WS_DP);
                    if (g == 0) pool_run<2>(U, DP, 0, run, F.lane); else if (g == 1) pool_run<4>(U, DP, 1, run, F.lane); else if (g == 2) pool_run<8>(U, DP, 2, run, F.lane); else pool_run<16>(U, DP, 3, run, F.lane); }
                for (int it = gw2; it < 2048; it += NGW2) conv_run((const bf16*)(ws + WS_U2), (const bf16*)(ws + WS_CB), LIN(6, 3 * CW), (bf16*)(ws + WS_YC), it, F.lane);
            }
#ifndef CONV_IN_P0
            constexpr int NFIVE = (M / 256) * (NZ / 256) - 4 * 256;
            if (F.G == 256 && (int)blockIdx.x >= NFIVE) { LAYERW(L); convert_weights(F, L, 1, ((int)blockIdx.x - NFIVE) * NWAVES + F.wave, (256 - NFIVE) * NWAVES); }
            else if (F.G != 256) { LAYERW(L); convert_weights(F, L, 1, gw, NGW); }
#endif
        }
        GRID_BAR();

        REPS(2) {
            PHASE_BEGIN();
            float gg = fabsf(LIN(7, HD)[F.lane] * LIN(8, HD)[F.lane]); gg = wave_max(gg);
            const float Cc = 8.0f * 1.4426950408889634f * gg;
            attn_units(F, F.vcu, F.G, BATCH * NH * 16, Cc);
        }
        GRID_BAR();

        REPS(3) {
            PHASE_BEGIN();
            pg8::StaticOrder so; so.init(M, D, F.G, (int)blockIdx.x); pg8::Unit t0; so.next(0, t0);
            REPS(33) combine_panel(F, t0.pm);
            VM_WAIT();
            for (int i = F.tid; i < 3 * 256; i += NTHREADS) ((LAS float*)(F.lds + BTAB_OFF))[i] = -1.4426950408889634f * LIN(3, 3 * D)[(i >> 8) * D + t0.pn * 256 + (i & 255)];
            rstd_panel_to_lds(F, t0.pm);
            P34Sched S{t0.pm, t0.pn, ws};
            pg8::EpiP34 E{(bf16*)(ws + WS_H + HC_MG + (size_t)t0.pm * (HC_BYTES - 256 * D * 2)), (pg8::u32x4*)(ws + WS_H + HC_GS + (size_t)t0.pm * HC_BYTES) + (size_t)t0.pn * 8192, (const LAS float*)(F.lds + BTAB_OFF), (const LAS float*)(F.lds + RSTAB_OFF)};
            pg8::gemm_phase_v<pg8::EpiP34, P34Sched, ALIGN_MULTI>(F.lds + RING_OFF, S, E, F.tid, ws);
        }
        GROUP_BAR(3 * l + 1);

        {
            PHASE_BEGIN();
            int pm5, q5; my_panel((int)blockIdx.x, pm5, q5);
            pg8::UniformSched S; S.init((const bf16*)(ws + WS_H + HC_MG + (size_t)pm5 * (HC_BYTES - 256 * D * 2)), (const bf16*)(ws + WS_WO), M, D, D, F.G, (int)blockIdx.x);
            pg8::EpiResNorm E{(bf16*)(ws + WS_XN), (float*)nullptr, (float*)(ws + WS_RSQ)};
            pg8::gemm_phase_v<pg8::EpiResNorm, pg8::UniformSched, false>(F.lds + RING_OFF, S, E, F.tid, ws);
        }
        GROUP_BAR(3 * l + 2);
        REPS(6) {
            PHASE_BEGIN();
            pg8::UniformSched S; S.init((const bf16*)(ws + WS_XN), (const bf16*)(ws + WS_W1), M, FF, D, F.G, (int)blockIdx.x);
            { int pm6, q6; my_panel((int)blockIdx.x, pm6, q6); rstd_panel_to_lds(F, pm6); }
            pg8::EpiRelu2 E{(bf16*)(ws + WS_H), (const LAS float*)(F.lds + RSTAB_OFF)};
            pg8::gemm_phase_v<pg8::EpiRelu2, pg8::UniformSched, ALIGN_MULTI>(F.lds + RING_OFF, S, E, F.tid, ws);
        }
        GROUP_BAR(3 * l + 3);
        REPS(40) { if (DUP == 40) { GRID_BAR(); GRID_BAR(); } }
        {
            PHASE_BEGIN();
            pg8::UniformSched S; S.init((const bf16*)(ws + WS_H), (const bf16*)(ws + WS_W2), M, D, FF, F.G, (int)blockIdx.x);
            const bool more = (lq + 1 < DEPTH);
            pg8::EpiResNorm E{(bf16*)(ws + WS_XN), more ? (float*)nullptr : args.out, (float*)(ws + WS_RSQ)};
            pg8::gemm_phase_v<pg8::EpiResNorm, pg8::UniformSched, false>(F.lds + RING_OFF, S, E, F.tid, ws);
        }
        if (l + 1 < DEPTH) EXEC_BAR();
    }
}

extern "C" void kernel_launch(void* const* d_in, const int* in_sizes, int n_in, void* d_out, int out_size, void* d_ws, size_t ws_size, hipStream_t stream) {
    static int grid = 0;
    if (grid == 0) {
        if (n_in != 16 || in_sizes[0] != M * D || out_size != M * D || ws_size < WS_END) { fprintf(stderr, "kernel_launch: unexpected shapes (n_in %d, in0 %d, out %d, ws %zu)\n", n_in, n_in > 0 ? in_sizes[0] : -1, out_size, ws_size); grid = -1; return; }
        int dev = 0, cus = 0, per_cu = 0;
        if (hipGetDevice(&dev) != hipSuccess || hipDeviceGetAttribute(&cus, hipDeviceAttributeMultiprocessorCount, dev) != hipSuccess) { grid = -1; return; }
        if (hipFuncSetAttribute((const void*)mega_fwd, hipFuncAttributeMaxDynamicSharedMemorySize, LDS_BYTES) != hipSuccess) { fprintf(stderr, "kernel_launch: hipFuncSetAttribute failed\n"); grid = -1; return; }
        if (hipOccupancyMaxActiveBlocksPerMultiprocessor(&per_cu, (const void*)mega_fwd, NTHREADS, LDS_BYTES) != hipSuccess || per_cu < 1) fprintf(stderr, "kernel_launch: occupancy query reports %d\n", per_cu);
        (void)hipGetLastError();
        grid = cus;
        if (grid != 256) fprintf(stderr, "kernel_launch: built for a 256-CU device (one output tile per workgroup in three phases); got %d CUs: results will be wrong\n", grid);
    }
    if (grid < 0) return;
    if (hipMemsetAsync((char*)d_ws + WS_CTL, 0, CTL_ZERO_BYTES, stream) != hipSuccess) { fprintf(stderr, "kernel_launch: memset failed\n"); return; }
    Args a{};
    for (int i = 0; i < 16; ++i) a.in[i] = (const float*)d_in[i];
    a.out = (float*)d_out; a.ws = (unsigned char*)d_ws;
    hipLaunchKernelGGL(mega_fwd, dim3(grid), dim3(NTHREADS), LDS_BYTES, stream, a);
    const hipError_t le = hipPeekAtLastError();
    if (le != hipSuccess) fprintf(stderr, "kernel_launch: launch failed: %s\n", hipGetErrorName(le));
}
```

```cpp
#include <hip/hip_runtime.h>
#define CONV_IN_P0 1
#include <cstdio>
#include <cstdint>
namespace pg8 {
#define PG8_LAS __attribute__((address_space(3)))
typedef unsigned short bf16_t;
typedef short bf16x8 __attribute__((ext_vector_type(8)));
typedef float f32x4 __attribute__((ext_vector_type(4)));
typedef unsigned u32x4 __attribute__((ext_vector_type(4)));
constexpr int BM = 256, BK = 64, HALF = 128, HTB = HALF * BK * 2  , STAGE_BYTES = 8 * HTB, NXCD = 8, WGM = 8;

__host__ __device__ __forceinline__ int lds_byte(int r, int c) { const int st = (r >> 4) * 2 + (c >> 5), rr = r & 15, cc = c & 31, ob = rr * 64 + cc * 2; return st * 1024 + (ob ^ (((ob >> 9) & 1) << 5)); }
__host__ __device__ __forceinline__ void stage_rc(int b, int& R, int& C) { const int st = b / 1024, sb = b % 1024, swz = sb ^ (((sb >> 9) & 1) << 5); R = (st >> 1) * 16 + swz / 64; C = (st & 1) * 32 + (swz % 64) / 2; }
__host__ __device__ __forceinline__ int perm32(int rho) { const int n = rho >> 4, i = rho & 15; return 8 * (i >> 2) + 4 * n + (i & 3); }

struct Unit { int pm, pn; };
struct Gemm { const bf16_t* A; const bf16_t* Bt; int M, N, K; };

struct StaticOrder {
    int nM, nN, nwg, G, c;
    __host__ __device__ void init(int M, int N, int G_, int c_) { nM = M / BM; nN = N / BM; nwg = nM * nN; G = G_; c = c_; }
    __host__ __device__ bool next(int i, Unit& u) const {
        const long L = (long)i * G + c; if (L >= nwg) return false;
        int wgid = (int)L; { const int q = nwg / NXCD, r = nwg % NXCD, xcd = wgid % NXCD, off = wgid / NXCD; wgid = (xcd < r ? xcd * (q + 1) : r * (q + 1) + (xcd - r) * q) + off; }
        const int nig = WGM * nN, gid = wgid / nig, fm = gid * WGM, gsz = (nM - fm) < WGM ? (nM - fm) : WGM;
        u.pm = fm + ((wgid % nig) % gsz); u.pn = (wgid % nig) / gsz; return true;
    }
    __device__ __forceinline__ void a_ready(const Unit&) const {}
    __device__ __forceinline__ void done(const Unit&) const {}
};

typedef float f32x2 __attribute__((ext_vector_type(2)));
typedef float f32x2_cv __attribute__((ext_vector_type(2))); typedef __bf16 bf16x2_cv __attribute__((ext_vector_type(2)));
__device__ __forceinline__ unsigned cvt_pk_bf16(float lo, float hi) { const f32x2_cv v = {lo, hi}; return __builtin_bit_cast(unsigned, __builtin_convertvector(v, bf16x2_cv)); }
__device__ __forceinline__ u32x4 pack8(const f32x4 v0, const f32x4 v1) { u32x4 w; w.x = cvt_pk_bf16(v0[0], v0[1]); w.y = cvt_pk_bf16(v0[2], v0[3]); w.z = cvt_pk_bf16(v1[0], v1[1]); w.w = cvt_pk_bf16(v1[2], v1[3]); return w; }
__device__ __forceinline__ f32x4 unpack_lo4(const u32x4 w) { f32x4 r; r[0] = __uint_as_float(w.x << 16); r[1] = __uint_as_float(w.x & 0xffff0000u); r[2] = __uint_as_float(w.y << 16); r[3] = __uint_as_float(w.y & 0xffff0000u); return r; }
__device__ __forceinline__ f32x4 unpack_hi4(const u32x4 w) { f32x4 r; r[0] = __uint_as_float(w.z << 16); r[1] = __uint_as_float(w.z & 0xffff0000u); r[2] = __uint_as_float(w.w << 16); r[3] = __uint_as_float(w.w & 0xffff0000u); return r; }

constexpr float QK_EPS = 1e-6f, NORM_EPS = 1e-6f;
constexpr float Q_PRESCALE = 0.125f * 1.4426950408889634f;
constexpr int MROWS = 16384, DMODEL = 1024;

struct UnitV { int pm, pn; const bf16_t* A; const bf16_t* Bt; int K; int tag; };

__device__ __forceinline__ void load_rstd(const PG8_LAS float* tab, int rloc0, float (&rs)[2][4]) {
#pragma unroll
    for (int ai = 0; ai < 2; ++ai)
#pragma unroll
        for (int m = 0; m < 4; ++m) rs[ai][m] = tab[rloc0 + ai * HALF + m * 16];
}

struct EpiZ {
    static constexpr bool PERM = true, AFTER_DRAIN = false;
    bf16_t *U, *CB, *U2, *Q, *K, *V; const float* qg; const float* kg; const PG8_LAS float* rstab;
    __device__ __forceinline__ void operator()(const f32x4 (&acc)[2][2][4][2], const UnitV& u, int wr, int wc, int fr, int fq) const {
        const int row0 = u.pm * BM + wr * 64 + fr; const int t = u.pn;
        float rs[2][4]; load_rstd(rstab, wr * 64 + fr, rs);
        if (t < 4 || t >= 14) {
            bf16_t* base; int ldc, colt;
            if (t < 2) { base = U; ldc = 512; colt = t * 256; } else if (t < 4) { base = CB; ldc = 512; colt = (t - 2) * 256; } else { base = V; ldc = 768; colt = (t - 14) * 256; }
            const int col0 = colt + wc * 32 + 8 * fq;
#pragma unroll
            for (int ai = 0; ai < 2; ++ai)
#pragma unroll
                for (int m = 0; m < 4; ++m) { bf16_t* rowp = base + (size_t)(row0 + ai * HALF + m * 16) * ldc + col0;
#pragma unroll
                    for (int bj = 0; bj < 2; ++bj) *(u32x4*)(rowp + bj * HALF) = pack8(acc[ai][bj][m][0] * rs[ai][m], acc[ai][bj][m][1] * rs[ai][m]); }
        } else if (t < 8) {
            const int col0 = (t - 4) * 128 + wc * 32 + 8 * fq;
#pragma unroll
            for (int ai = 0; ai < 2; ++ai)
#pragma unroll
                for (int m = 0; m < 4; ++m) { bf16_t* rowp = U2 + (size_t)(row0 + ai * HALF + m * 16) * 512 + col0; const float r2 = rs[ai][m] * rs[ai][m];
                    *(u32x4*)rowp = pack8(acc[ai][0][m][0] * acc[ai][1][m][0] * r2, acc[ai][0][m][1] * acc[ai][1][m][1] * r2); }
        } else {
            const bool isq = t < 11; const int hd = (isq ? t - 8 : t - 11) * 4 + wc;
            bf16_t* base = isq ? Q : K; const float* g = isq ? qg : kg; const float sc = isq ? Q_PRESCALE : 1.0f;
            f32x4 gv[2][2];
#pragma unroll
            for (int bj = 0; bj < 2; ++bj)
#pragma unroll
                for (int n = 0; n < 2; ++n) gv[bj][n] = *(const f32x4*)(g + 32 * bj + 8 * fq + 4 * n) * sc;
#pragma unroll
            for (int ai = 0; ai < 2; ++ai)
#pragma unroll
                for (int m = 0; m < 4; ++m) {
                    float ss = 0.f;
#pragma unroll
                    for (int bj = 0; bj < 2; ++bj)
#pragma unroll
                        for (int n = 0; n < 2; ++n) { const f32x4 x = acc[ai][bj][m][n]; ss += (x[0] * x[0] + x[1] * x[1]) + (x[2] * x[2] + x[3] * x[3]); }
                    ss += __shfl_xor(ss, 16); ss += __shfl_xor(ss, 32);
                    const float rr = rs[ai][m];
                    const float r = rr * __builtin_amdgcn_rsqf(rr * rr * ss * (1.0f / 64.0f) + QK_EPS);
                    bf16_t* rowp = base + (size_t)(row0 + ai * HALF + m * 16) * 768 + hd * 64 + 8 * fq;
#pragma unroll
                    for (int bj = 0; bj < 2; ++bj) *(u32x4*)(rowp + 32 * bj) = pack8(acc[ai][bj][m][0] * r * gv[bj][0], acc[ai][bj][m][1] * r * gv[bj][1]);
                }
        }
    }
};
struct EpiP34 {
    static constexpr bool PERM = true, AFTER_DRAIN = false;
    bf16_t* MG; u32x4* gs; const PG8_LAS float* btab; const PG8_LAS float* rstab;
    __device__ __forceinline__ void operator()(const f32x4 (&acc)[2][2][4][2], const UnitV& u, int wr, int wc, int fr, int fq) const {
        unsigned tidx = (unsigned)(((wr * 4 + wc) * 4 + fq) * 16 + fr); asm volatile("" : "+v"(tidx));
        const int row0 = u.pm * BM + wr * 64 + fr;
        if (u.tag & 1) {
#ifdef DUP
          for (int rep_ = 0; rep_ < ((DUP == 50) ? 2 : 1); ++rep_) {
#else
          {
#endif
            const int col0 = u.pn * BM + wc * 32 + 8 * fq;
            u32x4* gsb = gs;
            f32x4 bv[2][2];
#pragma unroll
            for (int bj = 0; bj < 2; ++bj)
#pragma unroll
                for (int n = 0; n < 2; ++n) bv[bj][n] = *(const PG8_LAS f32x4*)(btab + (u.pn >> 2) * BM + wc * 32 + 8 * fq + bj * HALF + 4 * n);
            float rs[2][4]; load_rstd(rstab, wr * 64 + fr, rs);
#pragma unroll
            for (int ai = 0; ai < 2; ++ai)
#pragma unroll
                for (int m = 0; m < 4; ++m) rs[ai][m] *= -1.4426950408889634f;
#pragma unroll
            for (int ai = 0; ai < 2; ++ai)
#pragma unroll
                for (int m = 0; m < 4; ++m)
#pragma unroll
                    for (int bj = 0; bj < 2; ++bj) { f32x4 v[2];
#pragma unroll
                        for (int n = 0; n < 2; ++n) {
                            const f32x4 a = acc[ai][bj][m][n], b = bv[bj][n]; const f32x2 rs2 = {rs[ai][m], rs[ai][m]}, one2 = {1.0f, 1.0f};
                            const f32x2 x0 = __builtin_elementwise_fma((f32x2){a[0], a[1]}, rs2, (f32x2){b[0], b[1]}), x1 = __builtin_elementwise_fma((f32x2){a[2], a[3]}, rs2, (f32x2){b[2], b[3]});
                            const f32x2 d0 = (f32x2){__builtin_amdgcn_exp2f(x0[0]), __builtin_amdgcn_exp2f(x0[1])} + one2, d1 = (f32x2){__builtin_amdgcn_exp2f(x1[0]), __builtin_amdgcn_exp2f(x1[1])} + one2;
                            v[n] = (f32x4){__builtin_amdgcn_rcpf(d0[0]), __builtin_amdgcn_rcpf(d0[1]), __builtin_amdgcn_rcpf(d1[0]), __builtin_amdgcn_rcpf(d1[1])}; }
                        (gsb + ((ai * 4 + m) * 2 + bj) * 512)[tidx] = pack8(v[0], v[1]); }
          }
        } else {
            const int col0 = u.pn * BM + wc * 32 + 8 * fq; const bool first = (u.tag == 0); const u32x4* gsb = gs;
#pragma unroll
            for (int ai = 0; ai < 2; ++ai) {
                u32x4 gw[4][2], mw[4][2];
#pragma unroll
                for (int m = 0; m < 4; ++m)
#pragma unroll
                    for (int bj = 0; bj < 2; ++bj) { gw[m][bj] = (gsb + ((ai * 4 + m) * 2 + bj) * 512)[tidx];
                        if (!first) mw[m][bj] = *(const u32x4*)(MG + (size_t)(row0 + ai * HALF + m * 16) * 1024 + col0 + bj * HALF); }
                asm volatile("" ::: "memory");
#pragma unroll
                for (int m = 0; m < 4; ++m)
#pragma unroll
                    for (int bj = 0; bj < 2; ++bj) {
                        f32x4 v0 = unpack_lo4(gw[m][bj]) * acc[ai][bj][m][0], v1 = unpack_hi4(gw[m][bj]) * acc[ai][bj][m][1];
                        if (!first) { v0 += unpack_lo4(mw[m][bj]); v1 += unpack_hi4(mw[m][bj]); }
                        *(u32x4*)(MG + (size_t)(row0 + ai * HALF + m * 16) * 1024 + col0 + bj * HALF) = pack8(v0, v1); }
                asm volatile("" ::: "memory");
            }
        }
    }
};
struct EpiResNorm {
    static constexpr bool PERM = true, AFTER_DRAIN = true;
    bf16_t* X; float* outf; float* rsq;
    __device__ __forceinline__ void fused(const f32x4 (&acc)[2][2][4][2], const UnitV& u, int wr, int wc, int fr, int fq, PG8_LAS unsigned char* lds, int wid, int lane) const {
        const int row0 = u.pm * BM + wr * 64 + fr, col0 = u.pn * BM + wc * 32 + 8 * fq;
        PG8_LAS float* P = (PG8_LAS float*)lds;
        u32x4 xb[2][4][2];
#pragma unroll
        for (int ai = 0; ai < 2; ++ai)
#pragma unroll
            for (int m = 0; m < 4; ++m)
#pragma unroll
                for (int bj = 0; bj < 2; ++bj) xb[ai][m][bj] = *(const u32x4*)(X + (size_t)(row0 + ai * HALF + m * 16) * 1024 + col0 + bj * HALF);
        asm volatile("" ::: "memory");
#pragma unroll
        for (int ai = 0; ai < 2; ++ai)
#pragma unroll
            for (int m = 0; m < 4; ++m) { const size_t off = (size_t)(row0 + ai * HALF + m * 16) * 1024 + col0; float ss = 0.f;
#pragma unroll
                for (int bj = 0; bj < 2; ++bj) { const u32x4 bw = xb[ai][m][bj];
                    const f32x4 v0 = unpack_lo4(bw) + acc[ai][bj][m][0], v1 = unpack_hi4(bw) + acc[ai][bj][m][1];
                    if (outf) { *(f32x4*)(outf + off + bj * HALF) = v0; *(f32x4*)(outf + off + bj * HALF + 4) = v1;
#if defined(DUP) && DUP == 60
                        asm volatile("" ::: "memory"); *(f32x4*)(outf + off + bj * HALF) = v0; *(f32x4*)(outf + off + bj * HALF + 4) = v1; asm volatile("" ::: "memory"); *(f32x4*)(outf + off + bj * HALF) = v0; *(f32x4*)(outf + off + bj * HALF + 4) = v1;
#endif
                    }
                    else { *(u32x4*)(X + off + bj * HALF) = pack8(v0, v1);
                        ss += ((v0[0] * v0[0] + v0[1] * v0[1]) + (v0[2] * v0[2] + v0[3] * v0[3])) + ((v1[0] * v1[0] + v1[1] * v1[1]) + (v1[2] * v1[2] + v1[3] * v1[3])); } }
                if (!outf) { ss += __shfl_xor(ss, 16); ss += __shfl_xor(ss, 32); if (fq == 0) P[(ai * HALF + wr * 64 + m * 16 + fr) * 4 + wc] = ss; } }
        if (!outf) {
            asm volatile("s_waitcnt lgkmcnt(0)" ::: "memory"); __builtin_amdgcn_s_barrier(); asm volatile("" ::: "memory");
            const int t = wid * 64 + lane;
            if (t < 256) { const PG8_LAS float* q = P + t * 4; rsq[(size_t)u.pn * MROWS + u.pm * BM + t] = (q[0] + q[1]) + (q[2] + q[3]); }
        }
    }
};
struct EpiRelu2 {
    static constexpr bool PERM = true, AFTER_DRAIN = false;
    bf16_t* H; const PG8_LAS float* rstab;
    __device__ __forceinline__ void operator()(const f32x4 (&acc)[2][2][4][2], const UnitV& u, int wr, int wc, int fr, int fq) const {
        const int row0 = u.pm * BM + wr * 64 + fr, col0 = u.pn * BM + wc * 32 + 8 * fq;
        float rs[2][4]; load_rstd(rstab, wr * 64 + fr, rs);
#pragma unroll
        for (int ai = 0; ai < 2; ++ai)
#pragma unroll
            for (int m = 0; m < 4; ++m) { bf16_t* rowp = H + (size_t)(row0 + ai * HALF + m * 16) * 4096 + col0;
#pragma unroll
                for (int bj = 0; bj < 2; ++bj) { f32x4 v[2];
#pragma unroll
                    for (int n = 0; n < 2; ++n) { const f32x4 x = __builtin_elementwise_max(acc[ai][bj][m][n] * rs[ai][m], (f32x4){0.f, 0.f, 0.f, 0.f}); v[n] = x * x; }
                    *(u32x4*)(rowp + bj * HALF) = pack8(v[0], v[1]); } }
    }
};

template <class Epi, class Sched, bool ALIGN_EPI = false>
__device__ __forceinline__ void gemm_phase_v(PG8_LAS unsigned char* lds, const Sched& S, const Epi& E, const int tid, const unsigned char* wsb) {
    const __amdgpu_buffer_rsrc_t srd = __builtin_amdgcn_make_buffer_rsrc((void*)wsb, (short)0, 0x7FFFFFFF, 0x00020000);
    const int wid = __builtin_amdgcn_readfirstlane(tid >> 6), lane = tid & 63, wr = wid >> 2, wc = wid & 3, fr = lane & 15, fq = lane >> 4;
    const unsigned kstep = (unsigned)(BK * 2);
    const unsigned ldsw = (unsigned)wid * 1024u;
    const int aoff = lds_byte(wr * 64 + fr, fq * 8), boff = lds_byte(wc * 32 + fr, fq * 8);
    unsigned rdA_ = (unsigned)(size_t)lds + (unsigned)aoff, rdB_ = (unsigned)(size_t)lds + 4u * HTB + (unsigned)boff; asm volatile("" : "+v"(rdA_), "+v"(rdB_));
    PG8_LAS unsigned char* const rdA = (PG8_LAS unsigned char*)(size_t)rdA_; PG8_LAS unsigned char* const rdB = (PG8_LAS unsigned char*)(size_t)rdB_;
#define PG8_SA(b, h) (((b) * 2 + (h)) * HTB)
#define PG8_SB(b, h) ((4 + (b) * 2 + (h)) * HTB)
#define PG8_STAGE(bufoff, goff, voff, hs_) do { _Pragma("unroll") for (int _i = 0; _i < 2; ++_i) \
        __builtin_amdgcn_raw_ptr_buffer_load_lds(srd, (PG8_LAS void*)(lds + (bufoff) + ldsw + _i * 8192), 16, (voff), (goff) + (unsigned)_i * ((hs_) >> 1), 0, 0); } while (0)
#define PG8_LDA(dst, b, h) do { _Pragma("unroll") for (int m = 0; m < 4; ++m) _Pragma("unroll") for (int k = 0; k < 2; ++k) dst[m][k] = *(const PG8_LAS bf16x8*)(rdA + PG8_SA(b, h) + m * 2048 + k * 1024); } while (0)
#define PG8_LDB(dst, b, h) do { _Pragma("unroll") for (int n = 0; n < 2; ++n) _Pragma("unroll") for (int k = 0; k < 2; ++k) dst[n][k] = *(const PG8_LAS bf16x8*)(rdB + (PG8_SB(b, h) - 4 * HTB) + n * 2048 + k * 1024); } while (0)
#define PG8_MMA(ai, bj, At, Bt) do { __builtin_amdgcn_s_setprio(1); _Pragma("unroll") for (int m = 0; m < 4; ++m) _Pragma("unroll") for (int n = 0; n < 2; ++n) _Pragma("unroll") for (int k = 0; k < 2; ++k) \
        acc[ai][bj][m][n] = __builtin_amdgcn_mfma_f32_16x16x32_bf16(Bt[n][k], At[m][k], acc[ai][bj][m][n], 0, 0, 0); __builtin_amdgcn_s_setprio(0); } while (0)
#define PG8_MMA0(ai, bj, At, Bt) do { __builtin_amdgcn_s_setprio(1); _Pragma("unroll") for (int m = 0; m < 4; ++m) _Pragma("unroll") for (int n = 0; n < 2; ++n) { \
        acc[ai][bj][m][n] = __builtin_amdgcn_mfma_f32_16x16x32_bf16(Bt[n][0], At[m][0], (f32x4){0.f, 0.f, 0.f, 0.f}, 0, 0, 0); \
        acc[ai][bj][m][n] = __builtin_amdgcn_mfma_f32_16x16x32_bf16(Bt[n][1], At[m][1], acc[ai][bj][m][n], 0, 0, 0); } __builtin_amdgcn_s_setprio(0); } while (0)
#define PG8_WAIT_V(n) asm volatile("s_waitcnt vmcnt(" #n ")" ::: "memory")
#define PG8_WAIT_L(n) asm volatile("s_waitcnt lgkmcnt(" #n ")" ::: "memory")
#define PG8_BAR __builtin_amdgcn_s_barrier()
#define PG8_SCHED __builtin_amdgcn_sched_barrier(0)
#define PG8_MKOFF(u_, vA_, vB_, hs_, pA_, pB_) do { const int K_ = (u_).K; int R_, C_; stage_rc(tid * 16, R_, C_); const int Rb_ = Epi::PERM ? ((R_ & ~31) + perm32(R_ & 31)) : R_; \
        vA_ = (unsigned)(R_ * K_ + C_) * 2u; vB_ = (unsigned)(Rb_ * K_ + C_) * 2u; \
        hs_ = (unsigned)(HALF * K_ * 2); pA_ = (unsigned)((const unsigned char*)(u_).A - wsb) + (unsigned)(u_).pm * (2u * hs_); pB_ = (unsigned)((const unsigned char*)(u_).Bt - wsb) + (unsigned)(u_).pn * (2u * hs_); } while (0)
    UnitV cur, nxt; int ui = 0;
    if (!S.next(0, cur)) return;
    f32x4 acc[2][2][4][2];
    bf16x8 At[4][2], B0[2][2], B1[2][2];
    unsigned vAc, vBc, vAn, vBn, hsc, hsn, cA, cB, nA, nB;
    PG8_MKOFF(cur, vAc, vBc, hsc, cA, cB);
    PG8_STAGE(PG8_SB(0, 0), cB, vBc, hsc); PG8_STAGE(PG8_SB(0, 1), cB + hsc, vBc, hsc); PG8_STAGE(PG8_SA(0, 0), cA, vAc, hsc); PG8_STAGE(PG8_SA(0, 1), cA + hsc, vAc, hsc);
    if (wr == 1) PG8_BAR;
    PG8_WAIT_V(2); PG8_BAR;
    PG8_STAGE(PG8_SB(1, 0), cB + kstep, vBc, hsc); PG8_STAGE(PG8_SA(1, 0), cA + kstep, vAc, hsc); PG8_STAGE(PG8_SB(1, 1), cB + hsc + kstep, vBc, hsc);
    PG8_WAIT_V(6); PG8_BAR;
    for (;;) {
        const bool has_next = S.next(ui + 1, nxt);
        if (!has_next) nxt = cur;
        PG8_MKOFF(nxt, vAn, vBn, hsn, nA, nB);
        const int nt = cur.K / BK;
        for (int t = 0; t < nt; t += 2) {
            const bool last = (t == nt - 2);
            const unsigned a1 = cA + (unsigned)(t + 1) * kstep;
            const unsigned a2 = last ? nA : cA + (unsigned)(t + 2) * kstep, b2 = last ? nB : cB + (unsigned)(t + 2) * kstep;
            const unsigned a3 = a2 + kstep, b3 = b2 + kstep;
            const unsigned hs2 = last ? hsn : hsc;
            const unsigned vA2 = last ? vAn : vAc, vB2 = last ? vBn : vBc;
            PG8_LDB(B0, 0, 0); PG8_LDB(B1, 0, 1); PG8_SCHED; PG8_LDA(At, 0, 0); PG8_STAGE(PG8_SA(1, 1), a1 + hsc, vAc, hsc);
            PG8_WAIT_V(8); PG8_WAIT_L(0); PG8_BAR; if (t == 0) { PG8_MMA0(0, 0, At, B0); PG8_MMA0(0, 1, At, B1); } else { PG8_MMA(0, 0, At, B0); PG8_MMA(0, 1, At, B1); } PG8_BAR; PG8_SCHED;
            PG8_LDA(At, 0, 1); PG8_STAGE(PG8_SB(0, 0), b2, vB2, hs2); PG8_STAGE(PG8_SB(0, 1), b2 + hs2, vB2, hs2); PG8_STAGE(PG8_SA(0, 0), a2, vA2, hs2);
            PG8_WAIT_V(8); PG8_WAIT_L(0); PG8_BAR; if (t == 0) { PG8_MMA0(1, 0, At, B0); PG8_MMA0(1, 1, At, B1); } else { PG8_MMA(1, 0, At, B0); PG8_MMA(1, 1, At, B1); } PG8_BAR; PG8_SCHED;
            PG8_LDB(B0, 1, 0); PG8_LDB(B1, 1, 1); PG8_SCHED; PG8_LDA(At, 1, 0); PG8_STAGE(PG8_SA(0, 1), a2 + hs2, vA2, hs2);
            PG8_WAIT_V(8); PG8_WAIT_L(0); PG8_BAR; PG8_MMA(0, 0, At, B0); PG8_MMA(0, 1, At, B1); PG8_BAR; PG8_SCHED;
            PG8_LDA(At, 1, 1); PG8_STAGE(PG8_SB(1, 0), b3, vB2, hs2); PG8_STAGE(PG8_SB(1, 1), b3 + hs2, vB2, hs2); PG8_STAGE(PG8_SA(1, 0), a3, vA2, hs2);
            PG8_WAIT_V(8); PG8_WAIT_L(0); PG8_BAR; PG8_MMA(1, 0, At, B0); PG8_MMA(1, 1, At, B1); PG8_BAR; PG8_SCHED;
        }
        if constexpr (ALIGN_EPI) { if (wr == 0) PG8_BAR; }
        if constexpr (!Epi::AFTER_DRAIN) { E(acc, cur, wr, wc, fr, fq); }
        if (!has_next) break;
        if constexpr (ALIGN_EPI && Sched::HOOK) S.unit_done(ui, wid);
        cur = nxt; cA = nA; cB = nB; hsc = hsn; vAc = vAn; vBc = vBn; ++ui;
        if constexpr (ALIGN_EPI) { if (wr == 1) PG8_BAR; }
    }
    PG8_WAIT_V(0);
    if constexpr (!ALIGN_EPI) { if (wr == 0) PG8_BAR; }
    PG8_BAR;
    if constexpr (Epi::AFTER_DRAIN) { E.fused(acc, cur, wr, wc, fr, fq, lds, wid, lane); }
#undef PG8_SA
#undef PG8_SB
#undef PG8_STAGE
#undef PG8_LDA
#undef PG8_LDB
#undef PG8_MMA
#undef PG8_MMA0
#undef PG8_WAIT_V
#undef PG8_WAIT_L
#undef PG8_BAR
#undef PG8_SCHED
#undef PG8_MKOFF
}
struct UniformSched {
    static constexpr bool HOOK = false;
    StaticOrder so; const bf16_t* A; const bf16_t* Bt; int K;
    __device__ __forceinline__ void init(const bf16_t* A_, const bf16_t* Bt_, int M, int N, int K_, int G, int c) { so.init(M, N, G, c); A = A_; Bt = Bt_; K = K_; }
    __device__ __forceinline__ bool next(int i, UnitV& u) const { Unit t; if (!so.next(i, t)) return false; u.pm = t.pm; u.pn = t.pn; u.A = A; u.Bt = Bt; u.K = K; u.tag = 0; return true; }
};
}

constexpr int NWAVES = 8, NTHREADS = NWAVES * 64;
constexpr int BATCH = 4, SEQ = 4096, D = 1024, M = BATCH * SEQ, DEPTH = 2;
constexpr int PW = 512, CW = 512, HD = 64, NH = 12, AW = 768, AO = 256, FF = 4096, INC = 7424;
constexpr int OFF_POOL = 0, OFF_CB = 512, OFF_CC = 1024, OFF_CX = 1536, OFF_Q = 2048, OFF_K = 2816, OFF_V = 3584, OFF_G = 4352;
constexpr int NZ = 4352, NG = 3072;
constexpr float RMS_EPS = 1e-6f;

constexpr size_t KiB = 1024, MiB = 1u << 20;
constexpr size_t WS_CTL = 0, CTL_ZERO_BYTES = 64 * KiB;
constexpr size_t WS_WZ = 1 * MiB;
constexpr size_t WS_WG = WS_WZ + (size_t)NZ * D * 2;
constexpr size_t WS_WPU = WS_WG + (size_t)NG * D * 2;
constexpr size_t WS_WCO = WS_WPU + (size_t)D * PW * 2;
constexpr size_t WS_WAU = WS_WCO + (size_t)D * CW * 2;
constexpr size_t WS_WO = WS_WAU + (size_t)D * AO * 2;
constexpr size_t WS_W1 = WS_WO + (size_t)D * D * 2;
constexpr size_t WS_W2 = WS_W1 + (size_t)FF * D * 2;
constexpr size_t WS_WEND = WS_W2 + (size_t)D * FF * 2;
constexpr size_t WS_XN = 36 * MiB;
constexpr size_t WS_U = 68 * MiB, WS_CB = 84 * MiB, WS_U2 = 100 * MiB, WS_Q = 116 * MiB, WS_K = 140 * MiB, WS_V = 164 * MiB;
constexpr size_t WS_H = 68 * MiB;
constexpr size_t HC_BYTES = 2 * MiB;
constexpr size_t HC_MG = 0;
constexpr size_t HC_GS = 512 * KiB;
constexpr size_t HC_YA = 1 * MiB;
constexpr size_t WS_OP = 196 * MiB;
constexpr size_t WS_LP = 220 * MiB;
constexpr size_t WS_DP = 220 * MiB + 768 * KiB;
constexpr size_t WS_YC = WS_DP + 16 * MiB;
constexpr size_t WS_END = WS_YC + 16 * MiB;
constexpr size_t WS_RSQ = WS_END;
static_assert(WS_WEND <= WS_XN && WS_RSQ + 4 * (size_t)M * 4 <= 256 * MiB && WS_V + 24 * MiB <= WS_OP && WS_H + (size_t)M * FF * 2 <= WS_OP, "d_ws map");
static_assert(M % (2 * 256 * 8) == 0, "xprep_rows2 pairs");
constexpr int CW_LE = 14336;
constexpr int CW_BAR = 4096, CW_GRP = 8192, CW_XID = 12288, CW_P1 = 12544;

constexpr int RING_OFF = 0, RING_BYTES = 131072;
constexpr int LDSCTL_OFF = RING_BYTES, MISC_OFF = LDSCTL_OFF + 320;
constexpr int BTAB_OFF = LDSCTL_OFF + 2048;
constexpr int RSTAB_OFF = LDSCTL_OFF + 1024;
constexpr int LDS_BYTES = 147456;

#define GAS __attribute__((address_space(1)))
#define LAS __attribute__((address_space(3)))
typedef unsigned short bf16;
typedef unsigned v4u __attribute__((ext_vector_type(4)));
typedef unsigned v2u __attribute__((ext_vector_type(2)));
typedef float f32x4 __attribute__((ext_vector_type(4)));
typedef float f32x16 __attribute__((ext_vector_type(16)));
typedef short bf16x8 __attribute__((ext_vector_type(8)));
typedef short s16x4 __attribute__((ext_vector_type(4)));
typedef GAS unsigned gu32;
#define RLX_AGENT __ATOMIC_RELAXED, __HIP_MEMORY_SCOPE_AGENT
#define LDS_WAIT() asm volatile("s_waitcnt lgkmcnt(0)" ::: "memory")
#define LDS_BARRIER() asm volatile("s_waitcnt lgkmcnt(0)\n\ts_barrier" ::: "memory")
#define VM_WAIT() asm volatile("s_waitcnt vmcnt(0)" ::: "memory")
__device__ __forceinline__ unsigned pk2(float lo, float hi) { return pg8::cvt_pk_bf16(lo, hi); }
__device__ __forceinline__ float bf_lo(unsigned w) { return __uint_as_float(w << 16); }
__device__ __forceinline__ float bf_hi(unsigned w) { return __uint_as_float(w & 0xffff0000u); }

#define XB_TMO      128
#define XB_XCNT(j)  (256  + 64 * (j))
#define XB_XSUB(j)  (1280 + 64 * (j))
#define XB_XGEN(j)  (2304 + 64 * (j))
#define XB_TOP      3328
#define XB_TOPGEN   3392
#define XCD_BAR_WORDS 3456
#define XB_SPIN_CAP (1u << 18)

__device__ __forceinline__ unsigned xb_ld(unsigned* p)              { return __hip_atomic_load(p, __ATOMIC_RELAXED, __HIP_MEMORY_SCOPE_AGENT); }
__device__ __forceinline__ unsigned xb_add(unsigned* p, unsigned v) { return __hip_atomic_fetch_add(p, v, __ATOMIC_RELAXED, __HIP_MEMORY_SCOPE_AGENT); }
__device__ __forceinline__ unsigned xb_xcc_id() { return (unsigned)__builtin_amdgcn_s_getreg((3 << 11) | 20) & 0xFu; }
#define XB_SPIN(cond, bar) do { unsigned _sp = 0; while (cond) { __builtin_amdgcn_s_sleep(1); \
    if ((++_sp & 255u) == 0u) { if (xb_ld(&(bar)[XB_TMO])) break; if (_sp > XB_SPIN_CAP) { atomicAdd(&(bar)[XB_TMO], 1u); break; } } } } while (0)

struct XcdBarrier {
    unsigned* bar; unsigned x; int wave;
    volatile LAS unsigned* st;
};

__device__ __forceinline__ bool xb_lane0() { unsigned o_ = ~0u; asm volatile("" : "+s"(o_)); return __builtin_amdgcn_mbcnt_hi(o_, __builtin_amdgcn_mbcnt_lo(o_, 0u)) == 0u; }
__device__ __forceinline__ XcdBarrier xcd_barrier_post(unsigned* bar, volatile LAS unsigned* st, int wave) {
    XcdBarrier b; b.bar = bar; b.x = xb_xcc_id(); b.st = st; b.wave = wave;
    if (wave == 0 && xb_lane0()) (void)xb_add(&bar[XB_XCNT(b.x)], 1u);
    return b;
}
__device__ __forceinline__ void xcd_barrier_complete(unsigned* bar, unsigned x, unsigned& nloc, unsigned& nx) {
    const unsigned G = gridDim.x * gridDim.y * gridDim.z;
    unsigned sum, cnt, mine, sp = 0u;
    for (;;) {
        sum = 0u; cnt = 0u; mine = 0u;
#pragma unroll
        for (unsigned j = 0; j < 16; ++j) { const unsigned c = xb_ld(&bar[XB_XCNT(j)]); sum += c; cnt += (c > 0u) ? 1u : 0u; mine = (j == x) ? c : mine; }
        if (sum == G) break;
        __builtin_amdgcn_s_sleep(1);
        if ((++sp & 255u) == 0u) { if (xb_ld(&bar[XB_TMO])) break; if (sp > XB_SPIN_CAP) { atomicAdd(&bar[XB_TMO], 1u); break; } }
    }
    nloc = mine > 0u ? mine : 1u; nx = cnt > 0u ? cnt : 1u;
}

template <bool FENCES = true>
__device__ __forceinline__ void xcd_barrier(const XcdBarrier& b) {
    asm volatile("s_waitcnt vmcnt(0)" ::: "memory");
    __syncthreads();
    if (b.wave == 0 && xb_lane0()) {
        unsigned* bar = b.bar;
        __builtin_amdgcn_s_waitcnt(0);
        unsigned nloc = b.st[0], nx = b.st[1];
        if (nloc == 0u) { xcd_barrier_complete(bar, b.x, nloc, nx); b.st[0] = nloc; b.st[1] = nx; }
        const unsigned old = xb_add(&bar[XB_XSUB(b.x)], 1u);
        const unsigned gen = old / nloc;
        if (old + 1u == (gen + 1u) * nloc) {
            if constexpr (FENCES) __builtin_amdgcn_fence(__ATOMIC_RELEASE, "agent");
            asm volatile("s_waitcnt vmcnt(0)" ::: "memory");
            const unsigned og = xb_add(&bar[XB_TOP], 1u);
            const unsigned tg = og / nx;
            if constexpr (FENCES) __builtin_amdgcn_fence(__ATOMIC_ACQUIRE, "agent");
            if (og + 1u == (tg + 1u) * nx) xb_add(&bar[XB_TOPGEN], 1u);
            else XB_SPIN(xb_ld(&bar[XB_TOPGEN]) == tg, bar);
            xb_add(&bar[XB_XGEN(b.x)], 1u);
            asm volatile("s_waitcnt vmcnt(0)" ::: "memory");
        } else {
            if constexpr (FENCES) __builtin_amdgcn_fence(__ATOMIC_ACQUIRE, "agent");
            XB_SPIN(xb_ld(&bar[XB_XGEN(b.x)]) == gen, bar);
            asm volatile("s_waitcnt vmcnt(0)" ::: "memory");
        }
    }
    __syncthreads();
}

__device__ __forceinline__ void group_barrier(const XcdBarrier& b, unsigned* cnt, unsigned target, unsigned* ids) {
    asm volatile("s_waitcnt vmcnt(0)" ::: "memory");
    __syncthreads();
    if (b.wave == 0 && xb_lane0()) {
        __builtin_amdgcn_s_waitcnt(0);
        unsigned same = b.st[2];
        if (same == 0u) { same = 1u;
#pragma unroll
            for (int j = 0; j < 4; ++j) same = (xb_ld(&ids[64 * j]) == b.x + 1u) ? same : 2u;
            b.st[2] = same; }
        if (same != 1u) { __builtin_amdgcn_fence(__ATOMIC_RELEASE, "agent"); asm volatile("s_waitcnt vmcnt(0)" ::: "memory"); }
        (void)xb_add(cnt, 1u);
        __builtin_amdgcn_fence(__ATOMIC_ACQUIRE, "agent");
        XB_SPIN(xb_ld(cnt) < target, b.bar);
        asm volatile("s_waitcnt vmcnt(0)" ::: "memory");
    }
    __syncthreads();
}

template <bool FENCES = true>
__device__ __forceinline__ void split_arrive(const XcdBarrier& b, int wave, unsigned* base, unsigned round) {
    asm volatile("s_waitcnt vmcnt(0)" ::: "memory");
    __builtin_amdgcn_s_barrier();
    if (wave == 0 && xb_lane0()) {
        __builtin_amdgcn_s_waitcnt(0);
        const unsigned nloc = b.st[0];
        const unsigned old = xb_add(&base[64 * b.x], 1u);
        if (old + 1u == round * nloc) {
            if constexpr (FENCES) __builtin_amdgcn_fence(__ATOMIC_RELEASE, "agent");
            asm volatile("s_waitcnt vmcnt(0)" ::: "memory");
            (void)xb_add(&base[64 * 16], 1u);
        }
    }
}
template <bool FENCES = true>
__device__ __forceinline__ void split_wait(const XcdBarrier& b, int wave, unsigned* base, unsigned round) {
    if (wave == 0 && xb_lane0()) {
        const unsigned nx = b.st[1];
        if constexpr (FENCES) __builtin_amdgcn_fence(__ATOMIC_ACQUIRE, "agent");
        XB_SPIN(xb_ld(&base[64 * 16]) < round * nx, b.bar);
        asm volatile("s_waitcnt vmcnt(0)" ::: "memory");
    }
    __syncthreads();
}


#ifndef ALIGN_MULTI
#define ALIGN_MULTI true
#endif
#ifndef DUP
#define DUP -1
#endif
#define REPS(k) for (int rep_ = 0; rep_ < ((DUP == (k)) ? 2 : 1); ++rep_)
struct Frame {
    LAS unsigned char* lds;
    volatile LAS unsigned* MISC;
    gu32* ctl;
    int tid, lane, wave;
    int vcu, G;
    unsigned char* ws;
};

__device__ __forceinline__ float wave_sum(float v) {
#pragma unroll
    for (int o = 1; o < 64; o <<= 1) v += __shfl_xor(v, o);
    return v;
}
__device__ __forceinline__ float wave_max(float v) {
#pragma unroll
    for (int o = 1; o < 64; o <<= 1) v = fmaxf(v, __shfl_xor(v, o));
    return v;
}

__device__ __forceinline__ void transpose_item(const float* W, int ldw, int k0, int srccol0, bf16* WT, int K, int destrow0, LAS float* scr, int lane, const float* gain = nullptr) {
    const int kr = lane >> 3, c4 = (lane & 7) * 4;
    f32x4 v[8];
#pragma unroll
    for (int i = 0; i < 8; ++i) v[i] = __builtin_nontemporal_load((const GAS f32x4*)(W + (size_t)(k0 + 8 * i + kr) * ldw + srccol0 + c4));
    if (gain) {
#pragma unroll
        for (int i = 0; i < 8; ++i) v[i] = v[i] * gain[k0 + 8 * i + kr]; }
#pragma unroll
    for (int i = 0; i < 8; ++i) { LAS float* d = scr + (8 * i + kr) * 33 + c4; d[0] = v[i].x; d[1] = v[i].y; d[2] = v[i].z; d[3] = v[i].w; }
    LDS_WAIT(); asm volatile("" ::: "memory");
    const int c = lane & 7;
#pragma unroll
    for (int j = 0; j < 4; ++j) { const int n = (lane >> 3) + 8 * j; const LAS float* s = scr + (8 * c) * 33 + n;
        v4u o; o.x = pk2(s[0 * 33], s[1 * 33]); o.y = pk2(s[2 * 33], s[3 * 33]); o.z = pk2(s[4 * 33], s[5 * 33]); o.w = pk2(s[6 * 33], s[7 * 33]);
        *(GAS v4u*)(WT + (size_t)(destrow0 + n) * K + k0 + 8 * c) = o; }
    LDS_WAIT(); asm volatile("" ::: "memory");
}
__device__ __forceinline__ int wz_src_col(int rb) {
    const int tile = rb >> 3, pb = rb & 7;
    if (tile < 4) return tile * 256 + pb * 32;
    if (tile < 8) return ((pb >> 2) ? OFF_CX : OFF_CC) + (tile - 4) * 128 + (pb & 3) * 32;
    if (tile < 14) { const int wc = pb & 3, bj = pb >> 2; return OFF_Q + (tile - 8) * 256 + 64 * wc + 32 * bj; }
    return OFF_V + (tile - 14) * 256 + pb * 32;
}
__device__ __forceinline__ void xprep_rows2(const float* x, bf16* xo, float* rsq, int row0, int row1, int lane) {
    const GAS f32x4* xa = (const GAS f32x4*)(x + (size_t)row0 * D) + lane; const GAS f32x4* xb = (const GAS f32x4*)(x + (size_t)row1 * D) + lane;
    f32x4 va[4], vb[4];
#pragma unroll
    for (int j = 0; j < 4; ++j) { va[j] = __builtin_nontemporal_load(xa + 64 * j); vb[j] = __builtin_nontemporal_load(xb + 64 * j); }
    float sa = 0.f, sb = 0.f;
#pragma unroll
    for (int j = 0; j < 4; ++j) { sa += (va[j].x * va[j].x + va[j].y * va[j].y) + (va[j].z * va[j].z + va[j].w * va[j].w); sb += (vb[j].x * vb[j].x + vb[j].y * vb[j].y) + (vb[j].z * vb[j].z + vb[j].w * vb[j].w); }
    sa = wave_sum(sa); sb = wave_sum(sb);
    GAS unsigned long long* oa = (GAS unsigned long long*)(xo + (size_t)row0 * D) + lane; GAS unsigned long long* ob = (GAS unsigned long long*)(xo + (size_t)row1 * D) + lane;
#pragma unroll
    for (int j = 0; j < 4; ++j) { oa[64 * j] = (unsigned long long)pk2(va[j].x, va[j].y) | ((unsigned long long)pk2(va[j].z, va[j].w) << 32);
                                  ob[64 * j] = (unsigned long long)pk2(vb[j].x, vb[j].y) | ((unsigned long long)pk2(vb[j].z, vb[j].w) << 32); }
    if (lane < 4) { rsq[(size_t)lane * M + row0] = (lane == 0) ? sa : 0.f; rsq[(size_t)lane * M + row1] = (lane == 0) ? sb : 0.f; }
}

struct LayerW {
    const float *norm_mix, *w_in, *b_gate, *pool_mix, *pool_scale, *conv_w, *q_gain, *k_gain, *w_pool_up, *w_conv_out, *w_attn_up, *w_o, *norm_mlp, *w_ff1, *w_ff2;
};

__device__ __forceinline__ void convert_weights(Frame& F, const LayerW& L, int part, int gw, int NGW) {
    LAS float* scr = (LAS float*)(F.lds + RING_OFF + F.wave * 16384);
    unsigned char* ws = F.ws;
    constexpr int I_WZ = (NZ / 32) * (D / 64), I_WG = (NG / 32) * (D / 64), I_CO = (D / 32) * (CW / 64), I_AU = (D / 32) * (AO / 64), I_WO = (D / 32) * (D / 64), I_W1 = (FF / 32) * (D / 64), I_W2 = (D / 32) * (FF / 64);
    if (part == 0) {
        for (int r = gw; r < I_WZ; r += NGW) { const int rb = r / (D / 64), kb = r % (D / 64); transpose_item(L.w_in, INC, kb * 64, wz_src_col(rb), (bf16*)(ws + WS_WZ), D, rb * 32, scr, F.lane, L.norm_mix); }
        return;
    }
    constexpr int NITEMS = I_WG + I_CO + I_AU + I_WO + I_W1 + I_W2;
    for (int it = gw; it < NITEMS; it += NGW) {
        int r = it;
        if (r < I_WG) { const int rb = r / (D / 64), kb = r % (D / 64); transpose_item(L.w_in, INC, kb * 64, OFF_G + rb * 32, (bf16*)(ws + WS_WG), D, rb * 32, scr, F.lane, L.norm_mix); continue; } r -= I_WG;
        if (r < I_CO) { const int rb = r / (CW / 64), kb = r % (CW / 64); transpose_item(L.w_conv_out, D, kb * 64, rb * 32, (bf16*)(ws + WS_WCO), CW, rb * 32, scr, F.lane); continue; } r -= I_CO;
        if (r < I_AU) { const int rb = r / (AO / 64), kb = r % (AO / 64); transpose_item(L.w_attn_up, D, kb * 64, rb * 32, (bf16*)(ws + WS_WAU), AO, rb * 32, scr, F.lane); continue; } r -= I_AU;
        if (r < I_WO) { const int rb = r / (D / 64), kb = r % (D / 64); transpose_item(L.w_o, D, kb * 64, rb * 32, (bf16*)(ws + WS_WO), D, rb * 32, scr, F.lane); continue; } r -= I_WO;
        if (r < I_W1) { const int rb = r / (D / 64), kb = r % (D / 64); transpose_item(L.w_ff1, FF, kb * 64, rb * 32, (bf16*)(ws + WS_W1), D, rb * 32, scr, F.lane, L.norm_mlp); continue; } r -= I_W1;
        { const int rb = r / (FF / 64), kb = r % (FF / 64); transpose_item(L.w_ff2, D, kb * 64, rb * 32, (bf16*)(ws + WS_W2), FF, rb * 32, scr, F.lane); }
    }
    for (int grp = gw >> 3; grp < (PW / 64) * (D / 32); grp += NGW >> 3) {
        const int kb = (grp / (D / 32)) * 8 + F.wave, nb = grp % (D / 32), k0 = kb * 8, g = k0 >> 7, n = nb * 32 + (F.lane & 31), dh = (F.lane >> 5) * 64;
        float a[8];
#pragma unroll
        for (int i = 0; i < 8; ++i) a[i] = 0.f;
        const float* mixr = L.pool_mix + (size_t)g * 128 * 128 + (size_t)(k0 & 127) * 128 + dh;
        const float* wp = L.w_pool_up + (size_t)(g * 128 + dh) * D + n; const float* sp = L.pool_scale + g * 128 + dh;
#pragma unroll 8
        for (int d = 0; d < 64; ++d) {
            const float wv = wp[(size_t)d * D] * sp[d];
#pragma unroll
            for (int i = 0; i < 8; ++i) a[i] += mixr[i * 128 + d] * wv;
        }
#pragma unroll
        for (int i = 0; i < 8; ++i) a[i] += __shfl_xor(a[i], 32);
        if (F.lane < 32) { v4u o; o.x = pk2(a[0], a[1]); o.y = pk2(a[2], a[3]); o.z = pk2(a[4], a[5]); o.w = pk2(a[6], a[7]);
            *(GAS v4u*)((bf16*)(ws + WS_WPU) + (size_t)n * PW + k0) = o; }
    }
}

template <int W> __device__ __forceinline__ void pool_run(const bf16* U, bf16* DP, int g, int run, int lane) {
    const int b = run >> 7, t0 = (run & 127) * 32; const size_t rowb = (size_t)b * SEQ;
    const int c = g * 128 + 2 * lane;
    unsigned w[32 + W];
#pragma unroll
    for (int k = 0; k < 32 + W; ++k) { const int tt = t0 - W + k; w[k] = (tt >= 0) ? *(const GAS unsigned*)(U + (rowb + tt) * PW + c) : 0u; }
    float s0 = 0.f, s1 = 0.f;
#pragma unroll
    for (int k = 0; k < W; ++k) { s0 += bf_lo(w[k]); s1 += bf_hi(w[k]); }
#pragma unroll
    for (int k = 0; k < 32; ++k) { const int t = t0 + k; const float n0 = bf_lo(w[W + k]), n1 = bf_hi(w[W + k]);
        s0 += n0 - bf_lo(w[k]); s1 += n1 - bf_hi(w[k]);
        const float inv = 1.0f / (float)((t + 1 < W) ? t + 1 : W);
        *(GAS unsigned*)(DP + (rowb + t) * PW + c) = pk2(s0 * inv - n0, s1 * inv - n1); }
}
__device__ __forceinline__ void conv_run(const bf16* U2, const bf16* CBp, const float* cw, bf16* YC, int run, int lane) {
    const int b = run >> 9, t0 = (run & 511) * 8; const size_t rowb = (size_t)b * SEQ; const int c = 8 * lane;
    v4u uw[10], bw[8];
    const int tw = t0 >= 2 ? t0 - 2 : 0;
    uw[0] = *(const GAS v4u*)(U2 + (rowb + tw) * CW + c); uw[1] = *(const GAS v4u*)(U2 + (rowb + tw + 1) * CW + c);
#pragma unroll
    for (int k = 0; k < 8; ++k) { uw[k + 2] = *(const GAS v4u*)(U2 + (rowb + t0 + k) * CW + c); bw[k] = *(const GAS v4u*)(CBp + (rowb + t0 + k) * CW + c); }
    float w0[8], w1[8], w2[8];
#pragma unroll
    for (int e = 0; e < 8; ++e) { w0[e] = cw[c + e]; w1[e] = cw[CW + c + e]; w2[e] = cw[2 * CW + c + e]; }
    asm volatile("" ::: "memory");
    if (t0 < 2) { uw[0] = (v4u){0u, 0u, 0u, 0u}; uw[1] = (v4u){0u, 0u, 0u, 0u}; }
#define CV_UNPK(q_, f_) do { const v4u t_ = (q_); f_[0] = bf_lo(t_.x); f_[1] = bf_hi(t_.x); f_[2] = bf_lo(t_.y); f_[3] = bf_hi(t_.y); f_[4] = bf_lo(t_.z); f_[5] = bf_hi(t_.z); f_[6] = bf_lo(t_.w); f_[7] = bf_hi(t_.w); } while (0)
#pragma unroll
    for (int k = 0; k < 8; ++k) { float p2[8], p1[8], u[8], bg[8], y[8];
        CV_UNPK(uw[k], p2); CV_UNPK(uw[k + 1], p1); CV_UNPK(uw[k + 2], u); CV_UNPK(bw[k], bg);
#pragma unroll
        for (int e = 0; e < 8; ++e) y[e] = bg[e] * (w2[e] * u[e] + w1[e] * p1[e] + w0[e] * p2[e]);
        v4u o; o.x = pk2(y[0], y[1]); o.y = pk2(y[2], y[3]); o.z = pk2(y[4], y[5]); o.w = pk2(y[6], y[7]);
        *(GAS v4u*)(YC + (rowb + t0 + k) * CW + c) = o; }
#undef CV_UNPK
}

constexpr int KPITCH = 144;
static_assert(384 * (192 + 144) <= RING_BYTES, "attention tiles");
constexpr int VPITCH = 192;
__device__ __forceinline__ int crow(int r, int hi) { return (r & 3) + 8 * (r >> 2) + 4 * hi; }
struct AttnCoord { int b, h, g, dil, rr, i0; };
__device__ __forceinline__ AttnCoord attn_decode(int unit) {
    AttnCoord c; c.b = unit / 192; const int rem = unit % 192; c.h = rem >> 4; const int s = rem & 15; c.g = c.h >> 2; const int lg = 2 * c.g; c.dil = 1 << lg;
    const int nub = 16 >> lg; c.rr = s / nub; c.i0 = (s % nub) * 256; return c;
}
__device__ __forceinline__ void attn_issue(const Frame& F, const AttnCoord& c, v4u (&vv)[6], v4u (&kk)[6], bf16x8 (&qn)[4]) {
    const bf16* Q = (const bf16*)(F.ws + WS_Q); const bf16* K = (const bf16*)(F.ws + WS_K); const bf16* V = (const bf16*)(F.ws + WS_V);
    const size_t rowb = (size_t)c.b * SEQ; const int tid = F.tid, r32 = F.lane & 31, hi = F.lane >> 5;
#pragma unroll
    for (int ps = 0; ps < 6; ++ps) { const int kl = ps * 64 + (tid >> 3), ch = tid & 7, ip = c.i0 - 128 + kl, ipc = ip < 0 ? 0 : ip;
        vv[ps] = *(const GAS v4u*)(V + (rowb + (size_t)ipc * c.dil + c.rr) * AW + c.h * HD + ch * 8);
        kk[ps] = *(const GAS v4u*)(K + (rowb + (size_t)ipc * c.dil + c.rr) * AW + c.h * HD + ch * 8); }
    const int iq = c.i0 + 32 * F.wave + r32;
    const bf16* qp = Q + (rowb + (size_t)iq * c.dil + c.rr) * AW + c.h * HD + 8 * hi;
#pragma unroll
    for (int d0 = 0; d0 < 4; ++d0) qn[d0] = *(const GAS bf16x8*)(qp + 16 * d0);
}
__device__ __forceinline__ void attn_units(Frame& F, int u0, int du, int nu, float Cc) {
    bf16* OP = (bf16*)(F.ws + WS_OP); float* LP = (float*)(F.ws + WS_LP);
    LAS unsigned char* Vs = F.lds + RING_OFF; LAS unsigned char* Ks = Vs + 384 * VPITCH;
    const int tid = F.tid, lane = F.lane, w = F.wave, r32 = lane & 31, hi = lane >> 5;
    v4u vv[6], kk[6]; bf16x8 qn[4];
    if (u0 < nu) attn_issue(F, attn_decode(u0), vv, kk, qn);
#pragma unroll 1
  for (int unit = u0; unit < nu; unit += du) {
    const AttnCoord c = attn_decode(unit);
    const int h = c.h, g = c.g, dil = c.dil, rr = c.rr, i0 = c.i0;
    const size_t rowb = (size_t)c.b * SEQ;
#pragma unroll
    for (int ps = 0; ps < 6; ++ps) { const int kl = ps * 64 + (tid >> 3), ch = tid & 7, ip = i0 - 128 + kl;
        v4u v = vv[ps]; if (ip < 0) v = (v4u){0u, 0u, 0u, 0u};
        *(LAS v4u*)(Vs + kl * VPITCH + ch * 16) = v;
        *(LAS v4u*)(Ks + kl * KPITCH + ch * 16) = kk[ps]; }
    const int iq = i0 + 32 * w + r32;
    bf16x8 qf[4];
#pragma unroll
    for (int d0 = 0; d0 < 4; ++d0) qf[d0] = qn[d0];
    LDS_BARRIER();
    if (unit + du < nu) attn_issue(F, attn_decode(unit + du), vv, kk, qn);
    const LAS unsigned char* kb = Ks + (32 * w + r32) * KPITCH + 16 * hi;
    bf16x8 kfn[4];
#pragma unroll
    for (int d0 = 0; d0 < 4; ++d0) kfn[d0] = *(const LAS bf16x8*)(kb + 32 * d0);
    f32x16 o0 = {}, o1 = {}; float lsum = 0.f;
    const int t4 = r32 - 4 * hi;
    const int trb = (4 * hi + ((lane & 15) >> 2)) * VPITCH + (16 * ((lane >> 4) & 1) + 4 * (lane & 3)) * 2;
#pragma unroll 1
    for (int kt = 0; kt < 5; ++kt) {
        const int kl0 = 32 * w + 32 * kt, ipb = i0 - 128 + kl0;
        bf16x8 kf[4];
#pragma unroll
        for (int d0 = 0; d0 < 4; ++d0) kf[d0] = kfn[d0];
        {
            const int ktn = kt < 4 ? kt + 1 : 4;
#pragma unroll
            for (int d0 = 0; d0 < 4; ++d0) kfn[d0] = *(const LAS bf16x8*)(kb + 32 * ktn * KPITCH + 32 * d0);
        }
        f32x16 sacc = {};
#pragma unroll
        for (int d0 = 0; d0 < 4; ++d0) sacc = __builtin_amdgcn_mfma_f32_32x32x16_bf16(kf[d0], qf[d0], sacc, 0, 0, 0);
        LAS unsigned char* vb = Vs + kl0 * VPITCH + trb;
        bf16x8 vf[4];
#pragma unroll
        for (int db = 0; db < 2; ++db)
#pragma unroll
            for (int st = 0; st < 2; ++st) {
                const s16x4 lo = __builtin_bit_cast(s16x4, __builtin_amdgcn_ds_read_tr16_b64_v4i16((LAS s16x4*)(vb + (16 * st) * VPITCH + db * 64)));
                const s16x4 hi4 = __builtin_bit_cast(s16x4, __builtin_amdgcn_ds_read_tr16_b64_v4i16((LAS s16x4*)(vb + (16 * st + 8) * VPITCH + db * 64)));
                vf[db * 2 + st] = (bf16x8){lo[0], lo[1], lo[2], lo[3], hi4[0], hi4[1], hi4[2], hi4[3]};
            }
        __builtin_amdgcn_sched_barrier(0);
        float p[16];
        if (ipb < 0) {
#pragma unroll
            for (int r = 0; r < 16; ++r) p[r] = 0.f;
        } else if (kt == 0) {
#pragma unroll
            for (int r = 0; r < 16; ++r) { p[r] = (t4 <= (r & 3) + 8 * (r >> 2)) ? __builtin_amdgcn_exp2f(sacc[r] - Cc) : 0.f; lsum += p[r]; }
        } else if (kt == 4) {
#pragma unroll
            for (int r = 0; r < 16; ++r) { p[r] = ((r & 3) + 8 * (r >> 2) <= t4) ? __builtin_amdgcn_exp2f(sacc[r] - Cc) : 0.f; lsum += p[r]; }
        } else {
#pragma unroll
            for (int r = 0; r < 16; ++r) { p[r] = __builtin_amdgcn_exp2f(sacc[r] - Cc); lsum += p[r]; }
        }
        v4u pb0, pb1;
        pb0.x = pk2(p[0], p[1]); pb0.y = pk2(p[2], p[3]); pb0.z = pk2(p[4], p[5]); pb0.w = pk2(p[6], p[7]);
        pb1.x = pk2(p[8], p[9]); pb1.y = pk2(p[10], p[11]); pb1.z = pk2(p[12], p[13]); pb1.w = pk2(p[14], p[15]);
        const bf16x8 pf0 = __builtin_bit_cast(bf16x8, pb0), pf1 = __builtin_bit_cast(bf16x8, pb1);
        asm volatile("" : "+v"(vf[0]), "+v"(vf[1]), "+v"(vf[2]), "+v"(vf[3]));
        o0 = __builtin_amdgcn_mfma_f32_32x32x16_bf16(vf[0], pf0, o0, 0, 0, 0);
        o0 = __builtin_amdgcn_mfma_f32_32x32x16_bf16(vf[1], pf1, o0, 0, 0, 0);
        o1 = __builtin_amdgcn_mfma_f32_32x32x16_bf16(vf[2], pf0, o1, 0, 0, 0);
        o1 = __builtin_amdgcn_mfma_f32_32x32x16_bf16(vf[3], pf1, o1, 0, 0, 0);
    }
    lsum += __shfl_xor(lsum, 32);
    const size_t orow = rowb + (size_t)iq * dil + rr;
    bf16* op = OP + ((size_t)g * M + orow) * AO + (h & 3) * HD;
#pragma unroll
    for (int pr = 0; pr < 4; ++pr) {
        const int ra = 2 * (pr & 1), rb = ra + 1;
        unsigned ax, ay, bx, by;
        if (pr < 2) { ax = pk2(o0[4 * ra], o0[4 * ra + 1]); ay = pk2(o0[4 * ra + 2], o0[4 * ra + 3]); bx = pk2(o0[4 * rb], o0[4 * rb + 1]); by = pk2(o0[4 * rb + 2], o0[4 * rb + 3]); }
        else        { ax = pk2(o1[4 * ra], o1[4 * ra + 1]); ay = pk2(o1[4 * ra + 2], o1[4 * ra + 3]); bx = pk2(o1[4 * rb], o1[4 * rb + 1]); by = pk2(o1[4 * rb + 2], o1[4 * rb + 3]); }
        { const auto r = __builtin_amdgcn_permlane32_swap(ax, bx, false, false); ax = r[0]; bx = r[1]; }
        { const auto r = __builtin_amdgcn_permlane32_swap(ay, by, false, false); ay = r[0]; by = r[1]; }
        v4u o; o.x = ax; o.y = ay; o.z = bx; o.w = by;
        *(GAS v4u*)(op + (pr < 2 ? 0 : 32) + 8 * ra + 8 * hi) = o; }
    if (hi == 0) LP[((size_t)g * M + orow) * 4 + (h & 3)] = lsum;
    LDS_BARRIER();
  }
}
__device__ __forceinline__ void combine_panel(Frame& F, int pm) {
    const bf16* OP = (const bf16*)(F.ws + WS_OP); const float* LP = (const float*)(F.ws + WS_LP); bf16* YA = (bf16*)(F.ws + WS_H + HC_YA + (size_t)pm * (HC_BYTES - 256 * AO * 2));
#pragma unroll 1
    for (int it0 = F.tid; it0 < 256 * 32; it0 += 4 * NTHREADS) {
        v4u w[4][3]; float lp[4][3];
#pragma unroll
        for (int q = 0; q < 4; ++q) { const int it = it0 + q * NTHREADS, m = pm * 256 + (it >> 5), ch = it & 31, j = ch >> 3;
#pragma unroll
            for (int g = 0; g < 3; ++g) { w[q][g] = *(const GAS v4u*)(OP + ((size_t)g * M + m) * AO + ch * 8); lp[q][g] = LP[((size_t)g * M + m) * 4 + j]; } }
        asm volatile("" ::: "memory");
#pragma unroll
        for (int q = 0; q < 4; ++q) { const int it = it0 + q * NTHREADS, m = pm * 256 + (it >> 5), ch = it & 31;
            float acc[8];
#pragma unroll
            for (int e = 0; e < 8; ++e) acc[e] = 0.f;
#pragma unroll
            for (int g = 0; g < 3; ++g) { const v4u x = w[q][g];
                acc[0] += bf_lo(x.x); acc[1] += bf_hi(x.x); acc[2] += bf_lo(x.y); acc[3] += bf_hi(x.y); acc[4] += bf_lo(x.z); acc[5] += bf_hi(x.z); acc[6] += bf_lo(x.w); acc[7] += bf_hi(x.w); }
            const float inv = 1.0f / ((lp[q][0] + lp[q][1]) + lp[q][2]);
            v4u o; o.x = pk2(acc[0] * inv, acc[1] * inv); o.y = pk2(acc[2] * inv, acc[3] * inv); o.z = pk2(acc[4] * inv, acc[5] * inv); o.w = pk2(acc[6] * inv, acc[7] * inv);
            *(GAS v4u*)(YA + (size_t)m * AO + ch * 8) = o; }
    }
}
__device__ __forceinline__ void rstd_panel_to_lds(Frame& F, int pm) {
    if (F.tid < 256) { const float* rsq = (const float*)(F.ws + WS_RSQ) + pm * 256 + F.tid;
        const float s4 = (rsq[0] + rsq[M]) + (rsq[2 * M] + rsq[3 * M]);
        ((LAS float*)(F.lds + RSTAB_OFF))[F.tid] = __builtin_amdgcn_rsqf(s4 * (1.0f / D) + RMS_EPS); }
    LDS_WAIT(); __syncthreads();
}
__device__ __forceinline__ void my_panel(int c, int& pm, int& q) { pm = 8 * (c & 7) + ((c >> 3) & 7); q = c >> 6; }
struct P1Sched {
    static constexpr bool HOOK = true;
    int pm, q; const bf16* A; const bf16* Bt; XcdBarrier xb; unsigned* base; unsigned round;
    __device__ __forceinline__ void unit_done(int ui, int wave) const { if (ui == 3) split_arrive(xb, wave, base, round); }
    __device__ __forceinline__ bool next(int i, pg8::UnitV& u) const {
        const int pn = q + 4 * i; if (pn >= NZ / 256) return false;
        int pm_ = pm; asm volatile("" : "+s"(pm_));
        u.pm = pm_; u.pn = pn; u.A = A; u.Bt = Bt; u.K = D; u.tag = 0; return true;
    }
};
struct P34Sched {
    static constexpr bool HOOK = false;
    int pm, pn; unsigned char* ws;
    __device__ __forceinline__ bool next(int i, pg8::UnitV& u) const {
        if (i >= ((DUP == 51) ? 7 : 6)) return false;
        if (i == 6) i = 4;
        const int br = i >> 1; int pm_ = pm, pn_ = pn; asm volatile("" : "+s"(pm_), "+s"(pn_));
        u.pm = pm_;
        if (!(i & 1)) { u.pn = 4 * br + pn_; u.A = (const bf16*)(ws + WS_XN); u.Bt = (const bf16*)(ws + WS_WG); u.K = D; u.tag = 2 * br + 1; }
        else { const size_t oa = (br == 0) ? WS_DP : (br == 1) ? WS_YC : WS_H + HC_YA + (size_t)pm_ * (HC_BYTES - 256 * AO * 2), ob = (br == 0) ? WS_WPU : (br == 1) ? WS_WCO : WS_WAU;
               u.pn = pn_; u.A = (const bf16*)(ws + oa); u.Bt = (const bf16*)(ws + ob); u.K = (br == 2) ? AO : PW; u.tag = 2 * br; }
        return true;
    }
};

struct Args { const float* in[16]; float* out; unsigned char* ws; };
#define PHASE_BEGIN() Frame F = F0; int lq = l; { int w_ = F0.wave; asm volatile("" : "+s"(w_)); unsigned o_ = ~0u; asm volatile("" : "+s"(o_)); int t_ = w_ * 64 + (int)__builtin_amdgcn_mbcnt_hi(o_, __builtin_amdgcn_mbcnt_lo(o_, 0u)); asm volatile("" : "+v"(t_)); asm volatile("" : "+s"(lq)); F.tid = t_; F.lane = t_ & 63; F.wave = __builtin_amdgcn_readfirstlane(t_ >> 6); } \
    unsigned char* const ws = F.ws; const int gw = F.vcu * NWAVES + F.wave, NGW = F.G * NWAVES; (void)gw; (void)NGW; (void)ws
#define LIN(k, stride) (args.in[k] + (size_t)lq * (stride))
__global__ void __launch_bounds__(NTHREADS, 2) mega_fwd(Args args) {
    extern __shared__ __attribute__((aligned(16))) unsigned char lds[];
    Frame F0;
    F0.lds = (LAS unsigned char*)lds;
    F0.MISC = (volatile LAS unsigned*)(F0.lds + MISC_OFF);
    F0.tid = threadIdx.x; F0.lane = F0.tid & 63; F0.wave = __builtin_amdgcn_readfirstlane(F0.tid >> 6);
    F0.G = gridDim.x; { const int bx = blockIdx.x; F0.vcu = (F0.G % 8 == 0) ? (bx % 8) * (F0.G / 8) + bx / 8 : bx; }
    F0.ws = args.ws; F0.ctl = (gu32*)(args.ws + WS_CTL);
    for (int u = F0.tid; u < (LDS_BYTES - LDSCTL_OFF) / 4; u += NTHREADS) ((LAS unsigned*)(F0.lds + LDSCTL_OFF))[u] = 0u;
    __syncthreads();
    unsigned* const bar_base = (unsigned*)(F0.ctl + CW_BAR);
    XcdBarrier bar = xcd_barrier_post(bar_base, F0.MISC + 8, F0.wave);
    if (F0.wave == 0 && xb_lane0()) (void)xb_add((unsigned*)(F0.ctl + CW_XID) + blockIdx.x, bar.x + 1u);
#define GRID_BAR() do { int w_ = F0.wave; unsigned o_ = CW_BAR; asm volatile("" : "+s"(w_), "+s"(o_)); bar.wave = w_; bar.bar = (unsigned*)(F0.ctl + o_); xcd_barrier(bar); } while (0)
#define EXEC_BAR() do { int w_ = F0.wave; unsigned o_ = CW_BAR; asm volatile("" : "+s"(w_), "+s"(o_)); bar.wave = w_; bar.bar = (unsigned*)(F0.ctl + o_); xcd_barrier<false>(bar); } while (0)
#define GROUP_BAR(n) do { int w_ = F0.wave; unsigned o_ = 0u; asm volatile("" : "+s"(w_), "+s"(o_)); bar.wave = w_; unsigned* const cb_ = (unsigned*)(F0.ctl + o_); bar.bar = cb_ + CW_BAR; \
        group_barrier(bar, cb_ + CW_GRP + 64 * ((int)blockIdx.x & 63), 4u * (unsigned)(n), cb_ + CW_XID + ((int)blockIdx.x & 63)); } while (0)

#pragma unroll 1
    for (int l = 0; l < DEPTH; ++l) {
#define LAYERW(L) LayerW L; L.norm_mix = LIN(1, D); L.w_in = LIN(2, (size_t)D * INC); L.pool_mix = LIN(4, 4 * 128 * 128); L.pool_scale = LIN(5, PW); \
            L.w_pool_up = LIN(9, (size_t)PW * D); L.w_conv_out = LIN(10, (size_t)CW * D); L.w_attn_up = LIN(11, (size_t)AO * D); L.w_o = LIN(12, (size_t)D * D); \
            L.w_ff1 = LIN(14, (size_t)D * FF); L.w_ff2 = LIN(15, (size_t)FF * D); L.norm_mlp = LIN(13, D)
        REPS(0) {
            PHASE_BEGIN();
            LAYERW(L);
            convert_weights(F, L, 0, gw, NGW);
            if (lq > 0) { unsigned ol_ = CW_LE; asm volatile("" : "+s"(ol_)); split_wait<false>(bar, F.wave, (unsigned*)(F0.ctl + ol_), (unsigned)lq); }
#ifdef CONV_IN_P0
            convert_weights(F, L, 1, gw, NGW);
#endif
            if (lq == 0) for (int m = gw; m < M; m += 2 * NGW) xprep_rows2(args.in[0], (bf16*)(ws + WS_XN), (float*)(ws + WS_RSQ), m, m + NGW, F.lane);
        }
        GRID_BAR();

        REPS(1) {
            PHASE_BEGIN();
            int pm0, q0; my_panel((int)blockIdx.x, pm0, q0);
            rstd_panel_to_lds(F, pm0);
            unsigned o1_ = CW_P1; asm volatile("" : "+s"(o1_)); unsigned* const p1b = (unsigned*)(F0.ctl + o1_);
            P1Sched S{pm0, q0, (const bf16*)(ws + WS_XN), (const bf16*)(ws + WS_WZ), bar, p1b, (unsigned)lq + 1u};
            pg8::EpiZ E{(bf16*)(ws + WS_U), (bf16*)(ws + WS_CB), (bf16*)(ws + WS_U2), (bf16*)(ws + WS_Q), (bf16*)(ws + WS_K), (bf16*)(ws + WS_V), LIN(7, HD), LIN(8, HD), (const LAS float*)(F.lds + RSTAB_OFF)};
            pg8::gemm_phase_v<pg8::EpiZ, P1Sched, ALIGN_MULTI>(F.lds + RING_OFF, S, E, F.tid, ws);
            if (q0 != 0) {
                split_arrive(bar, F.wave, p1b, (unsigned)lq + 1u); split_wait(bar, F.wave, p1b, (unsigned)lq + 1u);
                const int gw2 = ((q0 - 1) * 64 + ((int)blockIdx.x & 63)) * NWAVES + F.wave, NGW2 = 192 * NWAVES;
                for (int it = gw2; it < 2048; it += NGW2) { const int g = it & 3, run = it >> 2; const bf16* U = (const bf16*)(ws + WS_U); bf16* DP = (bf16*)(ws + WS_DP);
                    if (g == 0) pool_run<2>(U, DP, 0, run, F.lane); else if (g == 1) pool_run<4>(U, DP, 1, run, F.lane); else if (g == 2) pool_run<8>(U, DP, 2, run, F.lane); else pool_run<16>(U, DP, 3, run, F.lane); }
                for (int it = gw2; it < 2048; it += NGW2) conv_run((const bf16*)(ws + WS_U2), (const bf16*)(ws + WS_CB), LIN(6, 3 * CW), (bf16*)(ws + WS_YC), it, F.lane);
            }
#ifndef CONV_IN_P0
            constexpr int NFIVE = (M / 256) * (NZ / 256) - 4 * 256;
            if (F.G == 256 && (int)blockIdx.x >= NFIVE) { LAYERW(L); convert_weights(F, L, 1, ((int)blockIdx.x - NFIVE) * NWAVES + F.wave, (256 - NFIVE) * NWAVES); }
            else if (F.G != 256) { LAYERW(L); convert_weights(F, L, 1, gw, NGW); }
#endif
        }
        GRID_BAR();

        REPS(2) {
            PHASE_BEGIN();
            float gg = fabsf(LIN(7, HD)[F.lane] * LIN(8, HD)[F.lane]); gg = wave_max(gg);
            const float Cc = 8.0f * 1.4426950408889634f * gg;
            attn_units(F, F.vcu, F.G, BATCH * NH * 16, Cc);
        }
        GRID_BAR();

        REPS(3) {
            PHASE_BEGIN();
            pg8::StaticOrder so; so.init(M, D, F.G, (int)blockIdx.x); pg8::Unit t0; so.next(0, t0);
            REPS(33) combine_panel(F, t0.pm);
            VM_WAIT();
            for (int i = F.tid; i < 3 * 256; i += NTHREADS) ((LAS float*)(F.lds + BTAB_OFF))[i] = -1.4426950408889634f * LIN(3, 3 * D)[(i >> 8) * D + t0.pn * 256 + (i & 255)];
            rstd_panel_to_lds(F, t0.pm);
            P34Sched S{t0.pm, t0.pn, ws};
            pg8::EpiP34 E{(bf16*)(ws + WS_H + HC_MG + (size_t)t0.pm * (HC_BYTES - 256 * D * 2)), (pg8::u32x4*)(ws + WS_H + HC_GS + (size_t)t0.pm * HC_BYTES) + (size_t)t0.pn * 8192, (const LAS float*)(F.lds + BTAB_OFF), (const LAS float*)(F.lds + RSTAB_OFF)};
            pg8::gemm_phase_v<pg8::EpiP34, P34Sched, ALIGN_MULTI>(F.lds + RING_OFF, S, E, F.tid, ws);
        }
        GROUP_BAR(3 * l + 1);

        {
            PHASE_BEGIN();
            int pm5, q5; my_panel((int)blockIdx.x, pm5, q5);
            pg8::UniformSched S; S.init((const bf16*)(ws + WS_H + HC_MG + (size_t)pm5 * (HC_BYTES - 256 * D * 2)), (const bf16*)(ws + WS_WO), M, D, D, F.G, (int)blockIdx.x);
            pg8::EpiResNorm E{(bf16*)(ws + WS_XN), (float*)nullptr, (float*)(ws + WS_RSQ)};
            pg8::gemm_phase_v<pg8::EpiResNorm, pg8::UniformSched, false>(F.lds + RING_OFF, S, E, F.tid, ws);
        }
        GROUP_BAR(3 * l + 2);
        REPS(6) {
            PHASE_BEGIN();
            pg8::UniformSched S; S.init((const bf16*)(ws + WS_XN), (const bf16*)(ws + WS_W1), M, FF, D, F.G, (int)blockIdx.x);
            { int pm6, q6; my_panel((int)blockIdx.x, pm6, q6); rstd_panel_to_lds(F, pm6); }
            pg8::EpiRelu2 E{(bf16*)(ws + WS_H), (const LAS float*)(F.lds + RSTAB_OFF)};
            pg8::gemm_phase_v<pg8::EpiRelu2, pg8::UniformSched, ALIGN_MULTI>(F.lds + RING_OFF, S, E, F.tid, ws);
        }
        GROUP_BAR(3 * l + 3);
        REPS(40) { if (DUP == 40) { GRID_BAR(); GRID_BAR(); } }
        {
            PHASE_BEGIN();
            pg8::UniformSched S; S.init((const bf16*)(ws + WS_H), (const bf16*)(ws + WS_W2), M, D, FF, F.G, (int)blockIdx.x);
            const bool more = (lq + 1 < DEPTH);
            pg8::EpiResNorm E{(bf16*)(ws + WS_XN), more ? (float*)nullptr : args.out, (float*)(ws + WS_RSQ)};
            pg8::gemm_phase_v<pg8::EpiResNorm, pg8::UniformSched, false>(F.lds + RING_OFF, S, E, F.tid, ws);
        }
        if (l + 1 < DEPTH) { int w_ = F0.wave; unsigned ol_ = CW_LE; asm volatile("" : "+s"(w_), "+s"(ol_)); split_arrive<false>(bar, w_, (unsigned*)(F0.ctl + ol_), (unsigned)l + 1u); }
    }
}

extern "C" void kernel_launch(void* const* d_in, const int* in_sizes, int n_in, void* d_out, int out_size, void* d_ws, size_t ws_size, hipStream_t stream) {
    static int grid = 0;
    if (grid == 0) {
        if (n_in != 16 || in_sizes[0] != M * D || out_size != M * D || ws_size < WS_END) { fprintf(stderr, "kernel_launch: unexpected shapes (n_in %d, in0 %d, out %d, ws %zu)\n", n_in, n_in > 0 ? in_sizes[0] : -1, out_size, ws_size); grid = -1; return; }
        int dev = 0, cus = 0, per_cu = 0;
        if (hipGetDevice(&dev) != hipSuccess || hipDeviceGetAttribute(&cus, hipDeviceAttributeMultiprocessorCount, dev) != hipSuccess) { grid = -1; return; }
        if (hipFuncSetAttribute((const void*)mega_fwd, hipFuncAttributeMaxDynamicSharedMemorySize, LDS_BYTES) != hipSuccess) { fprintf(stderr, "kernel_launch: hipFuncSetAttribute failed\n"); grid = -1; return; }
        if (hipOccupancyMaxActiveBlocksPerMultiprocessor(&per_cu, (const void*)mega_fwd, NTHREADS, LDS_BYTES) != hipSuccess || per_cu < 1) fprintf(stderr, "kernel_launch: occupancy query reports %d\n", per_cu);
        (void)hipGetLastError();
        grid = cus;
        if (grid != 256) fprintf(stderr, "kernel_launch: built for a 256-CU device (one output tile per workgroup in three phases); got %d CUs: results will be wrong\n", grid);
    }
    if (grid < 0) return;
    if (hipMemsetAsync((char*)d_ws + WS_CTL, 0, CTL_ZERO_BYTES, stream) != hipSuccess) { fprintf(stderr, "kernel_launch: memset failed\n"); return; }
    Args a{};
    for (int i = 0; i < 16; ++i) a.in[i] = (const float*)d_in[i];
    a.out = (float*)d_out; a.ws = (unsigned char*)d_ws;
    hipLaunchKernelGGL(mega_fwd, dim3(grid), dim3(NTHREADS), LDS_BYTES, stream, a);
    const hipError_t le = hipPeekAtLastError();
    if (le != hipSuccess) fprintf(stderr, "kernel_launch: launch failed: %s\n", hipGetErrorName(le));
}
```

```cpp
#include <hip/hip_runtime.h>
#define CONV_IN_P0 1
#include <cstdio>
#include <cstdint>
namespace pg8 {
#define PG8_LAS __attribute__((address_space(3)))
typedef unsigned short bf16_t;
typedef short bf16x8 __attribute__((ext_vector_type(8)));
typedef float f32x4 __attribute__((ext_vector_type(4)));
typedef unsigned u32x4 __attribute__((ext_vector_type(4)));
constexpr int BM = 256, BK = 64, HALF = 128, HTB = HALF * BK * 2  , STAGE_BYTES = 8 * HTB, NXCD = 8, WGM = 8;

__host__ __device__ __forceinline__ int lds_byte(int r, int c) { const int st = (r >> 4) * 2 + (c >> 5), rr = r & 15, cc = c & 31, ob = rr * 64 + cc * 2; return st * 1024 + (ob ^ (((ob >> 9) & 1) << 5)); }
__host__ __device__ __forceinline__ void stage_rc(int b, int& R, int& C) { const int st = b / 1024, sb = b % 1024, swz = sb ^ (((sb >> 9) & 1) << 5); R = (st >> 1) * 16 + swz / 64; C = (st & 1) * 32 + (swz % 64) / 2; }
__host__ __device__ __forceinline__ int perm32(int rho) { const int n = rho >> 4, i = rho & 15; return 8 * (i >> 2) + 4 * n + (i & 3); }

struct Unit { int pm, pn; };
struct Gemm { const bf16_t* A; const bf16_t* Bt; int M, N, K; };

struct StaticOrder {
    int nM, nN, nwg, G, c;
    __host__ __device__ void init(int M, int N, int G_, int c_) { nM = M / BM; nN = N / BM; nwg = nM * nN; G = G_; c = c_; }
    __host__ __device__ bool next(int i, Unit& u) const {
        const long L = (long)i * G + c; if (L >= nwg) return false;
        int wgid = (int)L; { const int q = nwg / NXCD, r = nwg % NXCD, xcd = wgid % NXCD, off = wgid / NXCD; wgid = (xcd < r ? xcd * (q + 1) : r * (q + 1) + (xcd - r) * q) + off; }
        const int nig = WGM * nN, gid = wgid / nig, fm = gid * WGM, gsz = (nM - fm) < WGM ? (nM - fm) : WGM;
        u.pm = fm + ((wgid % nig) % gsz); u.pn = (wgid % nig) / gsz; return true;
    }
    __device__ __forceinline__ void a_ready(const Unit&) const {}
    __device__ __forceinline__ void done(const Unit&) const {}
};

typedef float f32x2 __attribute__((ext_vector_type(2)));
typedef float f32x2_cv __attribute__((ext_vector_type(2))); typedef __bf16 bf16x2_cv __attribute__((ext_vector_type(2)));
__device__ __forceinline__ unsigned cvt_pk_bf16(float lo, float hi) { const f32x2_cv v = {lo, hi}; return __builtin_bit_cast(unsigned, __builtin_convertvector(v, bf16x2_cv)); }
__device__ __forceinline__ u32x4 pack8(const f32x4 v0, const f32x4 v1) { u32x4 w; w.x = cvt_pk_bf16(v0[0], v0[1]); w.y = cvt_pk_bf16(v0[2], v0[3]); w.z = cvt_pk_bf16(v1[0], v1[1]); w.w = cvt_pk_bf16(v1[2], v1[3]); return w; }
__device__ __forceinline__ f32x4 unpack_lo4(const u32x4 w) { f32x4 r; r[0] = __uint_as_float(w.x << 16); r[1] = __uint_as_float(w.x & 0xffff0000u); r[2] = __uint_as_float(w.y << 16); r[3] = __uint_as_float(w.y & 0xffff0000u); return r; }
__device__ __forceinline__ f32x4 unpack_hi4(const u32x4 w) { f32x4 r; r[0] = __uint_as_float(w.z << 16); r[1] = __uint_as_float(w.z & 0xffff0000u); r[2] = __uint_as_float(w.w << 16); r[3] = __uint_as_float(w.w & 0xffff0000u); return r; }

constexpr float QK_EPS = 1e-6f, NORM_EPS = 1e-6f;
constexpr float Q_PRESCALE = 0.125f * 1.4426950408889634f;
constexpr int MROWS = 16384, DMODEL = 1024;

struct UnitV { int pm, pn; const bf16_t* A; const bf16_t* Bt; int K; int tag; };

__device__ __forceinline__ void load_rstd(const PG8_LAS float* tab, int rloc0, float (&rs)[2][4]) {
#pragma unroll
    for (int ai = 0; ai < 2; ++ai)
#pragma unroll
        for (int m = 0; m < 4; ++m) rs[ai][m] = tab[rloc0 + ai * HALF + m * 16];
}

struct EpiZ {
    static constexpr bool PERM = true, AFTER_DRAIN = false;
    bf16_t *U, *CB, *U2, *Q, *K, *V; const float* qg; const float* kg; const PG8_LAS float* rstab;
    __device__ __forceinline__ void operator()(const f32x4 (&acc)[2][2][4][2], const UnitV& u, int wr, int wc, int fr, int fq) const {
        const int row0 = u.pm * BM + wr * 64 + fr; const int t = u.pn;
        float rs[2][4]; load_rstd(rstab, wr * 64 + fr, rs);
        if (t < 4 || t >= 14) {
            bf16_t* base; int ldc, colt;
            if (t < 2) { base = U; ldc = 512; colt = t * 256; } else if (t < 4) { base = CB; ldc = 512; colt = (t - 2) * 256; } else { base = V; ldc = 768; colt = (t - 14) * 256; }
            const int col0 = colt + wc * 32 + 8 * fq;
#pragma unroll
            for (int ai = 0; ai < 2; ++ai)
#pragma unroll
                for (int m = 0; m < 4; ++m) { bf16_t* rowp = base + (size_t)(row0 + ai * HALF + m * 16) * ldc + col0;
#pragma unroll
                    for (int bj = 0; bj < 2; ++bj) *(u32x4*)(rowp + bj * HALF) = pack8(acc[ai][bj][m][0] * rs[ai][m], acc[ai][bj][m][1] * rs[ai][m]); }
        } else if (t < 8) {
            const int col0 = (t - 4) * 128 + wc * 32 + 8 * fq;
#pragma unroll
            for (int ai = 0; ai < 2; ++ai)
#pragma unroll
                for (int m = 0; m < 4; ++m) { bf16_t* rowp = U2 + (size_t)(row0 + ai * HALF + m * 16) * 512 + col0; const float r2 = rs[ai][m] * rs[ai][m];
                    *(u32x4*)rowp = pack8(acc[ai][0][m][0] * acc[ai][1][m][0] * r2, acc[ai][0][m][1] * acc[ai][1][m][1] * r2); }
        } else {
            const bool isq = t < 11; const int hd = (isq ? t - 8 : t - 11) * 4 + wc;
            bf16_t* base = isq ? Q : K; const float* g = isq ? qg : kg; const float sc = isq ? Q_PRESCALE : 1.0f;
            f32x4 gv[2][2];
#pragma unroll
            for (int bj = 0; bj < 2; ++bj)
#pragma unroll
                for (int n = 0; n < 2; ++n) gv[bj][n] = *(const f32x4*)(g + 32 * bj + 8 * fq + 4 * n) * sc;
#pragma unroll
            for (int ai = 0; ai < 2; ++ai)
#pragma unroll
                for (int m = 0; m < 4; ++m) {
                    float ss = 0.f;
#pragma unroll
                    for (int bj = 0; bj < 2; ++bj)
#pragma unroll
                        for (int n = 0; n < 2; ++n) { const f32x4 x = acc[ai][bj][m][n]; ss += (x[0] * x[0] + x[1] * x[1]) + (x[2] * x[2] + x[3] * x[3]); }
                    ss += __shfl_xor(ss, 16); ss += __shfl_xor(ss, 32);
                    const float rr = rs[ai][m];
                    const float r = rr * __builtin_amdgcn_rsqf(rr * rr * ss * (1.0f / 64.0f) + QK_EPS);
                    bf16_t* rowp = base + (size_t)(row0 + ai * HALF + m * 16) * 768 + hd * 64 + 8 * fq;
#pragma unroll
                    for (int bj = 0; bj < 2; ++bj) *(u32x4*)(rowp + 32 * bj) = pack8(acc[ai][bj][m][0] * r * gv[bj][0], acc[ai][bj][m][1] * r * gv[bj][1]);
                }
        }
    }
};
struct EpiP34 {
    static constexpr bool PERM = true, AFTER_DRAIN = false;
    bf16_t* MG; u32x4* gs; const PG8_LAS float* btab; const PG8_LAS float* rstab;
    __device__ __forceinline__ void operator()(const f32x4 (&acc)[2][2][4][2], const UnitV& u, int wr, int wc, int fr, int fq) const {
        unsigned tidx = (unsigned)(((wr * 4 + wc) * 4 + fq) * 16 + fr); asm volatile("" : "+v"(tidx));
        const int row0 = u.pm * BM + wr * 64 + fr;
        if (u.tag & 1) {
#ifdef DUP
          for (int rep_ = 0; rep_ < ((DUP == 50) ? 2 : 1); ++rep_) {
#else
          {
#endif
            const int col0 = u.pn * BM + wc * 32 + 8 * fq;
            u32x4* gsb = gs;
            f32x4 bv[2][2];
#pragma unroll
            for (int bj = 0; bj < 2; ++bj)
#pragma unroll
                for (int n = 0; n < 2; ++n) bv[bj][n] = *(const PG8_LAS f32x4*)(btab + (u.pn >> 2) * BM + wc * 32 + 8 * fq + bj * HALF + 4 * n);
            float rs[2][4]; load_rstd(rstab, wr * 64 + fr, rs);
#pragma unroll
            for (int ai = 0; ai < 2; ++ai)
#pragma unroll
                for (int m = 0; m < 4; ++m) rs[ai][m] *= -1.4426950408889634f;
#pragma unroll
            for (int ai = 0; ai < 2; ++ai)
#pragma unroll
                for (int m = 0; m < 4; ++m)
#pragma unroll
                    for (int bj = 0; bj < 2; ++bj) { f32x4 v[2];
#pragma unroll
                        for (int n = 0; n < 2; ++n) {
                            const f32x4 a = acc[ai][bj][m][n], b = bv[bj][n]; const f32x2 rs2 = {rs[ai][m], rs[ai][m]}, one2 = {1.0f, 1.0f};
                            const f32x2 x0 = __builtin_elementwise_fma((f32x2){a[0], a[1]}, rs2, (f32x2){b[0], b[1]}), x1 = __builtin_elementwise_fma((f32x2){a[2], a[3]}, rs2, (f32x2){b[2], b[3]});
                            const f32x2 d0 = (f32x2){__builtin_amdgcn_exp2f(x0[0]), __builtin_amdgcn_exp2f(x0[1])} + one2, d1 = (f32x2){__builtin_amdgcn_exp2f(x1[0]), __builtin_amdgcn_exp2f(x1[1])} + one2;
                            v[n] = (f32x4){__builtin_amdgcn_rcpf(d0[0]), __builtin_amdgcn_rcpf(d0[1]), __builtin_amdgcn_rcpf(d1[0]), __builtin_amdgcn_rcpf(d1[1])}; }
                        (gsb + ((ai * 4 + m) * 2 + bj) * 512)[tidx] = pack8(v[0], v[1]); }
          }
        } else {
            const int col0 = u.pn * BM + wc * 32 + 8 * fq; const bool first = (u.tag == 0); const u32x4* gsb = gs;
#pragma unroll
            for (int ai = 0; ai < 2; ++ai) {
                u32x4 gw[4][2], mw[4][2];
#pragma unroll
                for (int m = 0; m < 4; ++m)
#pragma unroll
                    for (int bj = 0; bj < 2; ++bj) { gw[m][bj] = (gsb + ((ai * 4 + m) * 2 + bj) * 512)[tidx];
                        if (!first) mw[m][bj] = *(const u32x4*)(MG + (size_t)(row0 + ai * HALF + m * 16) * 1024 + col0 + bj * HALF); }
                asm volatile("" ::: "memory");
#pragma unroll
                for (int m = 0; m < 4; ++m)
#pragma unroll
                    for (int bj = 0; bj < 2; ++bj) {
                        f32x4 v0 = unpack_lo4(gw[m][bj]) * acc[ai][bj][m][0], v1 = unpack_hi4(gw[m][bj]) * acc[ai][bj][m][1];
                        if (!first) { v0 += unpack_lo4(mw[m][bj]); v1 += unpack_hi4(mw[m][bj]); }
                        *(u32x4*)(MG + (size_t)(row0 + ai * HALF + m * 16) * 1024 + col0 + bj * HALF) = pack8(v0, v1); }
                asm volatile("" ::: "memory");
            }
        }
    }
};
struct EpiResNorm {
    static constexpr bool PERM = true, AFTER_DRAIN = true;
    bf16_t* X; float* outf; float* rsq;
    __device__ __forceinline__ void fused(const f32x4 (&acc)[2][2][4][2], const UnitV& u, int wr, int wc, int fr, int fq, PG8_LAS unsigned char* lds, int wid, int lane) const {
        const int row0 = u.pm * BM + wr * 64 + fr, col0 = u.pn * BM + wc * 32 + 8 * fq;
        PG8_LAS float* P = (PG8_LAS float*)lds;
        u32x4 xb[2][4][2];
#pragma unroll
        for (int ai = 0; ai < 2; ++ai)
#pragma unroll
            for (int m = 0; m < 4; ++m)
#pragma unroll
                for (int bj = 0; bj < 2; ++bj) xb[ai][m][bj] = *(const u32x4*)(X + (size_t)(row0 + ai * HALF + m * 16) * 1024 + col0 + bj * HALF);
        asm volatile("" ::: "memory");
#pragma unroll
        for (int ai = 0; ai < 2; ++ai)
#pragma unroll
            for (int m = 0; m < 4; ++m) { const size_t off = (size_t)(row0 + ai * HALF + m * 16) * 1024 + col0; float ss = 0.f;
#pragma unroll
                for (int bj = 0; bj < 2; ++bj) { const u32x4 bw = xb[ai][m][bj];
                    const f32x4 v0 = unpack_lo4(bw) + acc[ai][bj][m][0], v1 = unpack_hi4(bw) + acc[ai][bj][m][1];
                    if (outf) { *(f32x4*)(outf + off + bj * HALF) = v0; *(f32x4*)(outf + off + bj * HALF + 4) = v1;
#if defined(DUP) && DUP == 60
                        asm volatile("" ::: "memory"); *(f32x4*)(outf + off + bj * HALF) = v0; *(f32x4*)(outf + off + bj * HALF + 4) = v1; asm volatile("" ::: "memory"); *(f32x4*)(outf + off + bj * HALF) = v0; *(f32x4*)(outf + off + bj * HALF + 4) = v1;
#endif
                    }
                    else { *(u32x4*)(X + off + bj * HALF) = pack8(v0, v1);
                        ss += ((v0[0] * v0[0] + v0[1] * v0[1]) + (v0[2] * v0[2] + v0[3] * v0[3])) + ((v1[0] * v1[0] + v1[1] * v1[1]) + (v1[2] * v1[2] + v1[3] * v1[3])); } }
                if (!outf) { ss += __shfl_xor(ss, 16); ss += __shfl_xor(ss, 32); if (fq == 0) P[(ai * HALF + wr * 64 + m * 16 + fr) * 4 + wc] = ss; } }
        if (!outf) {
            asm volatile("s_waitcnt lgkmcnt(0)" ::: "memory"); __builtin_amdgcn_s_barrier(); asm volatile("" ::: "memory");
            const int t = wid * 64 + lane;
            if (t < 256) { const PG8_LAS float* q = P + t * 4; rsq[(size_t)u.pn * MROWS + u.pm * BM + t] = (q[0] + q[1]) + (q[2] + q[3]); }
        }
    }
};
struct EpiRelu2 {
    static constexpr bool PERM = true, AFTER_DRAIN = false;
    bf16_t* H; const PG8_LAS float* rstab;
    __device__ __forceinline__ void operator()(const f32x4 (&acc)[2][2][4][2], const UnitV& u, int wr, int wc, int fr, int fq) const {
        const int row0 = u.pm * BM + wr * 64 + fr, col0 = u.pn * BM + wc * 32 + 8 * fq;
        float rs[2][4]; load_rstd(rstab, wr * 64 + fr, rs);
#pragma unroll
        for (int ai = 0; ai < 2; ++ai)
#pragma unroll
            for (int m = 0; m < 4; ++m) { bf16_t* rowp = H + (size_t)(row0 + ai * HALF + m * 16) * 4096 + col0;
#pragma unroll
                for (int bj = 0; bj < 2; ++bj) { f32x4 v[2];
#pragma unroll
                    for (int n = 0; n < 2; ++n) { const f32x4 x = __builtin_elementwise_max(acc[ai][bj][m][n] * rs[ai][m], (f32x4){0.f, 0.f, 0.f, 0.f}); v[n] = x * x; }
                    *(u32x4*)(rowp + bj * HALF) = pack8(v[0], v[1]); } }
    }
};

template <class Epi, class Sched, bool ALIGN_EPI = false>
__device__ __forceinline__ void gemm_phase_v(PG8_LAS unsigned char* lds, const Sched& S, const Epi& E, const int tid, const unsigned char* wsb) {
    const __amdgpu_buffer_rsrc_t srd = __builtin_amdgcn_make_buffer_rsrc((void*)wsb, (short)0, 0x7FFFFFFF, 0x00020000);
    const int wid = __builtin_amdgcn_readfirstlane(tid >> 6), lane = tid & 63, wr = wid >> 2, wc = wid & 3, fr = lane & 15, fq = lane >> 4;
    const unsigned kstep = (unsigned)(BK * 2);
    const unsigned ldsw = (unsigned)wid * 1024u;
    const int aoff = lds_byte(wr * 64 + fr, fq * 8), boff = lds_byte(wc * 32 + fr, fq * 8);
    unsigned rdA_ = (unsigned)(size_t)lds + (unsigned)aoff, rdB_ = (unsigned)(size_t)lds + 4u * HTB + (unsigned)boff; asm volatile("" : "+v"(rdA_), "+v"(rdB_));
    PG8_LAS unsigned char* const rdA = (PG8_LAS unsigned char*)(size_t)rdA_; PG8_LAS unsigned char* const rdB = (PG8_LAS unsigned char*)(size_t)rdB_;
#define PG8_SA(b, h) (((b) * 2 + (h)) * HTB)
#define PG8_SB(b, h) ((4 + (b) * 2 + (h)) * HTB)
#define PG8_STAGE(bufoff, goff, voff, hs_) do { _Pragma("unroll") for (int _i = 0; _i < 2; ++_i) \
        __builtin_amdgcn_raw_ptr_buffer_load_lds(srd, (PG8_LAS void*)(lds + (bufoff) + ldsw + _i * 8192), 16, (voff), (goff) + (unsigned)_i * ((hs_) >> 1), 0, 0); } while (0)
#define PG8_LDA(dst, b, h) do { _Pragma("unroll") for (int m = 0; m < 4; ++m) _Pragma("unroll") for (int k = 0; k < 2; ++k) dst[m][k] = *(const PG8_LAS bf16x8*)(rdA + PG8_SA(b, h) + m * 2048 + k * 1024); } while (0)
#define PG8_LDB(dst, b, h) do { _Pragma("unroll") for (int n = 0; n < 2; ++n) _Pragma("unroll") for (int k = 0; k < 2; ++k) dst[n][k] = *(const PG8_LAS bf16x8*)(rdB + (PG8_SB(b, h) - 4 * HTB) + n * 2048 + k * 1024); } while (0)
#define PG8_MMA(ai, bj, At, Bt) do { __builtin_amdgcn_s_setprio(1); _Pragma("unroll") for (int m = 0; m < 4; ++m) _Pragma("unroll") for (int n = 0; n < 2; ++n) _Pragma("unroll") for (int k = 0; k < 2; ++k) \
        acc[ai][bj][m][n] = __builtin_amdgcn_mfma_f32_16x16x32_bf16(Bt[n][k], At[m][k], acc[ai][bj][m][n], 0, 0, 0); __builtin_amdgcn_s_setprio(0); } while (0)
#define PG8_MMA0(ai, bj, At, Bt) do { __builtin_amdgcn_s_setprio(1); _Pragma("unroll") for (int m = 0; m < 4; ++m) _Pragma("unroll") for (int n = 0; n < 2; ++n) { \
        acc[ai][bj][m][n] = __builtin_amdgcn_mfma_f32_16x16x32_bf16(Bt[n][0], At[m][0], (f32x4){0.f, 0.f, 0.f, 0.f}, 0, 0, 0); \
        acc[ai][bj][m][n] = __builtin_amdgcn_mfma_f32_16x16x32_bf16(Bt[n][1], At[m][1], acc[ai][bj][m][n], 0, 0, 0); } __builtin_amdgcn_s_setprio(0); } while (0)
#define PG8_WAIT_V(n) asm volatile("s_waitcnt vmcnt(" #n ")" ::: "memory")
#define PG8_WAIT_L(n) asm volatile("s_waitcnt lgkmcnt(" #n ")" ::: "memory")
#define PG8_BAR __builtin_amdgcn_s_barrier()
#define PG8_SCHED __builtin_amdgcn_sched_barrier(0)
#define PG8_MKOFF(u_, vA_, vB_, hs_, pA_, pB_) do { const int K_ = (u_).K; int R_, C_; stage_rc(tid * 16, R_, C_); const int Rb_ = Epi::PERM ? ((R_ & ~31) + perm32(R_ & 31)) : R_; \
        vA_ = (unsigned)(R_ * K_ + C_) * 2u; vB_ = (unsigned)(Rb_ * K_ + C_) * 2u; \
        hs_ = (unsigned)(HALF * K_ * 2); pA_ = (unsigned)((const unsigned char*)(u_).A - wsb) + (unsigned)(u_).pm * (2u * hs_); pB_ = (unsigned)((const unsigned char*)(u_).Bt - wsb) + (unsigned)(u_).pn * (2u * hs_); } while (0)
    UnitV cur, nxt; int ui = 0;
    if (!S.next(0, cur)) return;
    f32x4 acc[2][2][4][2];
    bf16x8 At[4][2], B0[2][2], B1[2][2];
    unsigned vAc, vBc, vAn, vBn, hsc, hsn, cA, cB, nA, nB;
    PG8_MKOFF(cur, vAc, vBc, hsc, cA, cB);
    PG8_STAGE(PG8_SB(0, 0), cB, vBc, hsc); PG8_STAGE(PG8_SB(0, 1), cB + hsc, vBc, hsc); PG8_STAGE(PG8_SA(0, 0), cA, vAc, hsc); PG8_STAGE(PG8_SA(0, 1), cA + hsc, vAc, hsc);
    if (wr == 1) PG8_BAR;
    PG8_WAIT_V(2); PG8_BAR;
    PG8_STAGE(PG8_SB(1, 0), cB + kstep, vBc, hsc); PG8_STAGE(PG8_SA(1, 0), cA + kstep, vAc, hsc); PG8_STAGE(PG8_SB(1, 1), cB + hsc + kstep, vBc, hsc);
    PG8_WAIT_V(6); PG8_BAR;
    for (;;) {
        const bool has_next = S.next(ui + 1, nxt);
        if (!has_next) nxt = cur;
        PG8_MKOFF(nxt, vAn, vBn, hsn, nA, nB);
        const int nt = cur.K / BK;
        for (int t = 0; t < nt; t += 2) {
            const bool last = (t == nt - 2);
            const unsigned a1 = cA + (unsigned)(t + 1) * kstep;
            const unsigned a2 = last ? nA : cA + (unsigned)(t + 2) * kstep, b2 = last ? nB : cB + (unsigned)(t + 2) * kstep;
            const unsigned a3 = a2 + kstep, b3 = b2 + kstep;
            const unsigned hs2 = last ? hsn : hsc;
            const unsigned vA2 = last ? vAn : vAc, vB2 = last ? vBn : vBc;
            PG8_LDB(B0, 0, 0); PG8_LDB(B1, 0, 1); PG8_SCHED; PG8_LDA(At, 0, 0); PG8_STAGE(PG8_SA(1, 1), a1 + hsc, vAc, hsc);
            PG8_WAIT_V(8); PG8_WAIT_L(0); PG8_BAR; if (t == 0) { PG8_MMA0(0, 0, At, B0); PG8_MMA0(0, 1, At, B1); } else { PG8_MMA(0, 0, At, B0); PG8_MMA(0, 1, At, B1); } PG8_BAR; PG8_SCHED;
            PG8_LDA(At, 0, 1); PG8_STAGE(PG8_SB(0, 0), b2, vB2, hs2); PG8_STAGE(PG8_SB(0, 1), b2 + hs2, vB2, hs2); PG8_STAGE(PG8_SA(0, 0), a2, vA2, hs2);
            PG8_WAIT_V(8); PG8_WAIT_L(0); PG8_BAR; if (t == 0) { PG8_MMA0(1, 0, At, B0); PG8_MMA0(1, 1, At, B1); } else { PG8_MMA(1, 0, At, B0); PG8_MMA(1, 1, At, B1); } PG8_BAR; PG8_SCHED;
            PG8_LDB(B0, 1, 0); PG8_LDB(B1, 1, 1); PG8_SCHED; PG8_LDA(At, 1, 0); PG8_STAGE(PG8_SA(0, 1), a2 + hs2, vA2, hs2);
            PG8_WAIT_V(8); PG8_WAIT_L(0); PG8_BAR; PG8_MMA(0, 0, At, B0); PG8_MMA(0, 1, At, B1); PG8_BAR; PG8_SCHED;
            PG8_LDA(At, 1, 1); PG8_STAGE(PG8_SB(1, 0), b3, vB2, hs2); PG8_STAGE(PG8_SB(1, 1), b3 + hs2, vB2, hs2); PG8_STAGE(PG8_SA(1, 0), a3, vA2, hs2);
            PG8_WAIT_V(8); PG8_WAIT_L(0); PG8_BAR; PG8_MMA(1, 0, At, B0); PG8_MMA(1, 1, At, B1); PG8_BAR; PG8_SCHED;
        }
        if constexpr (ALIGN_EPI) { if (wr == 0) PG8_BAR; }
        if constexpr (!Epi::AFTER_DRAIN) { E(acc, cur, wr, wc, fr, fq); }
        if (!has_next) break;
        if constexpr (ALIGN_EPI && Sched::HOOK) S.unit_done(ui, wid);
        cur = nxt; cA = nA; cB = nB; hsc = hsn; vAc = vAn; vBc = vBn; ++ui;
        if constexpr (ALIGN_EPI) { if (wr == 1) PG8_BAR; }
    }
    PG8_WAIT_V(0);
    if constexpr (!ALIGN_EPI) { if (wr == 0) PG8_BAR; }
    PG8_BAR;
    if constexpr (Epi::AFTER_DRAIN) { E.fused(acc, cur, wr, wc, fr, fq, lds, wid, lane); }
#undef PG8_SA
#undef PG8_SB
#undef PG8_STAGE
#undef PG8_LDA
#undef PG8_LDB
#undef PG8_MMA
#undef PG8_MMA0
#undef PG8_WAIT_V
#undef PG8_WAIT_L
#undef PG8_BAR
#undef PG8_SCHED
#undef PG8_MKOFF
}
struct UniformSched {
    static constexpr bool HOOK = false;
    StaticOrder so; const bf16_t* A; const bf16_t* Bt; int K;
    __device__ __forceinline__ void init(const bf16_t* A_, const bf16_t* Bt_, int M, int N, int K_, int G, int c) { so.init(M, N, G, c); A = A_; Bt = Bt_; K = K_; }
    __device__ __forceinline__ bool next(int i, UnitV& u) const { Unit t; if (!so.next(i, t)) return false; u.pm = t.pm; u.pn = t.pn; u.A = A; u.Bt = Bt; u.K = K; u.tag = 0; return true; }
};
}

constexpr int NWAVES = 8, NTHREADS = NWAVES * 64;
constexpr int BATCH = 4, SEQ = 4096, D = 1024, M = BATCH * SEQ, DEPTH = 2;
constexpr int PW = 512, CW = 512, HD = 64, NH = 12, AW = 768, AO = 256, FF = 4096, INC = 7424;
constexpr int OFF_POOL = 0, OFF_CB = 512, OFF_CC = 1024, OFF_CX = 1536, OFF_Q = 2048, OFF_K = 2816, OFF_V = 3584, OFF_G = 4352;
constexpr int NZ = 4352, NG = 3072;
constexpr float RMS_EPS = 1e-6f;

constexpr size_t KiB = 1024, MiB = 1u << 20;
constexpr size_t WS_CTL = 0, CTL_ZERO_BYTES = 128 * KiB;
constexpr size_t WS_WZ = 1 * MiB;
constexpr size_t WS_WG = WS_WZ + (size_t)NZ * D * 2;
constexpr size_t WS_WPU = WS_WG + (size_t)NG * D * 2;
constexpr size_t WS_WCO = WS_WPU + (size_t)D * PW * 2;
constexpr size_t WS_WAU = WS_WCO + (size_t)D * CW * 2;
constexpr size_t WS_WO = WS_WAU + (size_t)D * AO * 2;
constexpr size_t WS_W1 = WS_WO + (size_t)D * D * 2;
constexpr size_t WS_W2 = WS_W1 + (size_t)FF * D * 2;
constexpr size_t WS_WEND = WS_W2 + (size_t)D * FF * 2;
constexpr size_t WS_XN = 36 * MiB;
constexpr size_t WS_U = 68 * MiB, WS_CB = 84 * MiB, WS_U2 = 100 * MiB, WS_Q = 116 * MiB, WS_K = 140 * MiB, WS_V = 164 * MiB;
constexpr size_t WS_H = 68 * MiB;
constexpr size_t HC_BYTES = 2 * MiB;
constexpr size_t HC_MG = 0;
constexpr size_t HC_GS = 512 * KiB;
constexpr size_t HC_YA = 1 * MiB;
constexpr size_t WS_OP = 196 * MiB;
constexpr size_t WS_LP = 220 * MiB;
constexpr size_t WS_DP = 220 * MiB + 768 * KiB;
constexpr size_t WS_YC = WS_DP + 16 * MiB;
constexpr size_t WS_END = WS_YC + 16 * MiB;
constexpr size_t WS_RSQ = WS_END;
static_assert(WS_WEND <= WS_XN && WS_RSQ + 4 * (size_t)M * 4 <= 256 * MiB && WS_V + 24 * MiB <= WS_OP && WS_H + (size_t)M * FF * 2 <= WS_OP, "d_ws map");
static_assert(M % (2 * 256 * 8) == 0, "xprep_rows2 pairs");
constexpr int CW_G0 = 16384;
static_assert((CW_G0 + 64 * 17) * 4 <= (int)CTL_ZERO_BYTES, "control words");
constexpr int CW_LE = 14336;
constexpr int CW_BAR = 4096, CW_GRP = 8192, CW_XID = 12288, CW_P1 = 12544;

constexpr int RING_OFF = 0, RING_BYTES = 131072;
constexpr int LDSCTL_OFF = RING_BYTES, MISC_OFF = LDSCTL_OFF + 320;
constexpr int BTAB_OFF = LDSCTL_OFF + 2048;
constexpr int RSTAB_OFF = LDSCTL_OFF + 1024;
constexpr int LDS_BYTES = 147456;

#define GAS __attribute__((address_space(1)))
#define LAS __attribute__((address_space(3)))
typedef unsigned short bf16;
typedef unsigned v4u __attribute__((ext_vector_type(4)));
typedef unsigned v2u __attribute__((ext_vector_type(2)));
typedef float f32x4 __attribute__((ext_vector_type(4)));
typedef float f32x16 __attribute__((ext_vector_type(16)));
typedef short bf16x8 __attribute__((ext_vector_type(8)));
typedef short s16x4 __attribute__((ext_vector_type(4)));
typedef GAS unsigned gu32;
#define RLX_AGENT __ATOMIC_RELAXED, __HIP_MEMORY_SCOPE_AGENT
#define LDS_WAIT() asm volatile("s_waitcnt lgkmcnt(0)" ::: "memory")
#define LDS_BARRIER() asm volatile("s_waitcnt lgkmcnt(0)\n\ts_barrier" ::: "memory")
#define VM_WAIT() asm volatile("s_waitcnt vmcnt(0)" ::: "memory")
__device__ __forceinline__ unsigned pk2(float lo, float hi) { return pg8::cvt_pk_bf16(lo, hi); }
__device__ __forceinline__ float bf_lo(unsigned w) { return __uint_as_float(w << 16); }
__device__ __forceinline__ float bf_hi(unsigned w) { return __uint_as_float(w & 0xffff0000u); }

#define XB_TMO      128
#define XB_XCNT(j)  (256  + 64 * (j))
#define XB_XSUB(j)  (1280 + 64 * (j))
#define XB_XGEN(j)  (2304 + 64 * (j))
#define XB_TOP      3328
#define XB_TOPGEN   3392
#define XCD_BAR_WORDS 3456
#define XB_SPIN_CAP (1u << 18)

__device__ __forceinline__ unsigned xb_ld(unsigned* p)              { return __hip_atomic_load(p, __ATOMIC_RELAXED, __HIP_MEMORY_SCOPE_AGENT); }
__device__ __forceinline__ unsigned xb_add(unsigned* p, unsigned v) { return __hip_atomic_fetch_add(p, v, __ATOMIC_RELAXED, __HIP_MEMORY_SCOPE_AGENT); }
__device__ __forceinline__ unsigned xb_xcc_id() { return (unsigned)__builtin_amdgcn_s_getreg((3 << 11) | 20) & 0xFu; }
#define XB_SPIN(cond, bar) do { unsigned _sp = 0; while (cond) { __builtin_amdgcn_s_sleep(1); \
    if ((++_sp & 255u) == 0u) { if (xb_ld(&(bar)[XB_TMO])) break; if (_sp > XB_SPIN_CAP) { atomicAdd(&(bar)[XB_TMO], 1u); break; } } } } while (0)

struct XcdBarrier {
    unsigned* bar; unsigned x; int wave;
    volatile LAS unsigned* st;
};

__device__ __forceinline__ bool xb_lane0() { unsigned o_ = ~0u; asm volatile("" : "+s"(o_)); return __builtin_amdgcn_mbcnt_hi(o_, __builtin_amdgcn_mbcnt_lo(o_, 0u)) == 0u; }
__device__ __forceinline__ XcdBarrier xcd_barrier_post(unsigned* bar, volatile LAS unsigned* st, int wave) {
    XcdBarrier b; b.bar = bar; b.x = xb_xcc_id(); b.st = st; b.wave = wave;
    if (wave == 0 && xb_lane0()) (void)xb_add(&bar[XB_XCNT(b.x)], 1u);
    return b;
}
__device__ __forceinline__ void xcd_barrier_complete(unsigned* bar, unsigned x, unsigned& nloc, unsigned& nx) {
    const unsigned G = gridDim.x * gridDim.y * gridDim.z;
    unsigned sum, cnt, mine, sp = 0u;
    for (;;) {
        sum = 0u; cnt = 0u; mine = 0u;
#pragma unroll
        for (unsigned j = 0; j < 16; ++j) { const unsigned c = xb_ld(&bar[XB_XCNT(j)]); sum += c; cnt += (c > 0u) ? 1u : 0u; mine = (j == x) ? c : mine; }
        if (sum == G) break;
        __builtin_amdgcn_s_sleep(1);
        if ((++sp & 255u) == 0u) { if (xb_ld(&bar[XB_TMO])) break; if (sp > XB_SPIN_CAP) { atomicAdd(&bar[XB_TMO], 1u); break; } }
    }
    nloc = mine > 0u ? mine : 1u; nx = cnt > 0u ? cnt : 1u;
}

template <bool FENCES = true>
__device__ __forceinline__ void xcd_barrier(const XcdBarrier& b) {
    asm volatile("s_waitcnt vmcnt(0)" ::: "memory");
    __syncthreads();
    if (b.wave == 0 && xb_lane0()) {
        unsigned* bar = b.bar;
        __builtin_amdgcn_s_waitcnt(0);
        unsigned nloc = b.st[0], nx = b.st[1];
        if (nloc == 0u) { xcd_barrier_complete(bar, b.x, nloc, nx); b.st[0] = nloc; b.st[1] = nx; }
        const unsigned old = xb_add(&bar[XB_XSUB(b.x)], 1u);
        const unsigned gen = old / nloc;
        if (old + 1u == (gen + 1u) * nloc) {
            if constexpr (FENCES) __builtin_amdgcn_fence(__ATOMIC_RELEASE, "agent");
            asm volatile("s_waitcnt vmcnt(0)" ::: "memory");
            const unsigned og = xb_add(&bar[XB_TOP], 1u);
            const unsigned tg = og / nx;
            if constexpr (FENCES) __builtin_amdgcn_fence(__ATOMIC_ACQUIRE, "agent");
            if (og + 1u == (tg + 1u) * nx) xb_add(&bar[XB_TOPGEN], 1u);
            else XB_SPIN(xb_ld(&bar[XB_TOPGEN]) == tg, bar);
            xb_add(&bar[XB_XGEN(b.x)], 1u);
            asm volatile("s_waitcnt vmcnt(0)" ::: "memory");
        } else {
            if constexpr (FENCES) __builtin_amdgcn_fence(__ATOMIC_ACQUIRE, "agent");
            XB_SPIN(xb_ld(&bar[XB_XGEN(b.x)]) == gen, bar);
            asm volatile("s_waitcnt vmcnt(0)" ::: "memory");
        }
    }
    __syncthreads();
}

__device__ __forceinline__ void group_barrier(const XcdBarrier& b, unsigned* cnt, unsigned target, unsigned* ids) {
    asm volatile("s_waitcnt vmcnt(0)" ::: "memory");
    __syncthreads();
    if (b.wave == 0 && xb_lane0()) {
        __builtin_amdgcn_s_waitcnt(0);
        unsigned same = b.st[2];
        if (same == 0u) { same = 1u;
#pragma unroll
            for (int j = 0; j < 4; ++j) same = (xb_ld(&ids[64 * j]) == b.x + 1u) ? same : 2u;
            b.st[2] = same; }
        if (same != 1u) { __builtin_amdgcn_fence(__ATOMIC_RELEASE, "agent"); asm volatile("s_waitcnt vmcnt(0)" ::: "memory"); }
        (void)xb_add(cnt, 1u);
        __builtin_amdgcn_fence(__ATOMIC_ACQUIRE, "agent");
        XB_SPIN(xb_ld(cnt) < target, b.bar);
        asm volatile("s_waitcnt vmcnt(0)" ::: "memory");
    }
    __syncthreads();
}

template <bool FENCES = true>
__device__ __forceinline__ void split_arrive(const XcdBarrier& b, int wave, unsigned* base, unsigned round) {
    asm volatile("s_waitcnt vmcnt(0)" ::: "memory");
    __builtin_amdgcn_s_barrier();
    if (wave == 0 && xb_lane0()) {
        __builtin_amdgcn_s_waitcnt(0);
        const unsigned nloc = b.st[0];
        const unsigned old = xb_add(&base[64 * b.x], 1u);
        if (old + 1u == round * nloc) {
            if constexpr (FENCES) __builtin_amdgcn_fence(__ATOMIC_RELEASE, "agent");
            asm volatile("s_waitcnt vmcnt(0)" ::: "memory");
            (void)xb_add(&base[64 * 16], 1u);
        }
    }
}
template <bool FENCES = true>
__device__ __forceinline__ void split_wait(const XcdBarrier& b, int wave, unsigned* base, unsigned round) {
    if (wave == 0 && xb_lane0()) {
        const unsigned nx = b.st[1];
        if constexpr (FENCES) __builtin_amdgcn_fence(__ATOMIC_ACQUIRE, "agent");
        XB_SPIN(xb_ld(&base[64 * 16]) < round * nx, b.bar);
        asm volatile("s_waitcnt vmcnt(0)" ::: "memory");
    }
    __syncthreads();
}


#ifndef ALIGN_MULTI
#define ALIGN_MULTI true
#endif
#ifndef DUP
#define DUP -1
#endif
#define REPS(k) for (int rep_ = 0; rep_ < ((DUP == (k)) ? 2 : 1); ++rep_)
struct Frame {
    LAS unsigned char* lds;
    volatile LAS unsigned* MISC;
    gu32* ctl;
    int tid, lane, wave;
    int vcu, G;
    unsigned char* ws;
};

__device__ __forceinline__ float wave_sum(float v) {
#pragma unroll
    for (int o = 1; o < 64; o <<= 1) v += __shfl_xor(v, o);
    return v;
}
__device__ __forceinline__ float wave_max(float v) {
#pragma unroll
    for (int o = 1; o < 64; o <<= 1) v = fmaxf(v, __shfl_xor(v, o));
    return v;
}

__device__ __forceinline__ void transpose_item(const float* W, int ldw, int k0, int srccol0, bf16* WT, int K, int destrow0, LAS float* scr, int lane, const float* gain = nullptr) {
    const int kr = lane >> 3, c4 = (lane & 7) * 4;
    f32x4 v[8];
#pragma unroll
    for (int i = 0; i < 8; ++i) v[i] = __builtin_nontemporal_load((const GAS f32x4*)(W + (size_t)(k0 + 8 * i + kr) * ldw + srccol0 + c4));
    if (gain) {
#pragma unroll
        for (int i = 0; i < 8; ++i) v[i] = v[i] * gain[k0 + 8 * i + kr]; }
#pragma unroll
    for (int i = 0; i < 8; ++i) { LAS float* d = scr + (8 * i + kr) * 33 + c4; d[0] = v[i].x; d[1] = v[i].y; d[2] = v[i].z; d[3] = v[i].w; }
    LDS_WAIT(); asm volatile("" ::: "memory");
    const int c = lane & 7;
#pragma unroll
    for (int j = 0; j < 4; ++j) { const int n = (lane >> 3) + 8 * j; const LAS float* s = scr + (8 * c) * 33 + n;
        v4u o; o.x = pk2(s[0 * 33], s[1 * 33]); o.y = pk2(s[2 * 33], s[3 * 33]); o.z = pk2(s[4 * 33], s[5 * 33]); o.w = pk2(s[6 * 33], s[7 * 33]);
        *(GAS v4u*)(WT + (size_t)(destrow0 + n) * K + k0 + 8 * c) = o; }
    LDS_WAIT(); asm volatile("" ::: "memory");
}
__device__ __forceinline__ int wz_src_col(int rb) {
    const int tile = rb >> 3, pb = rb & 7;
    if (tile < 4) return tile * 256 + pb * 32;
    if (tile < 8) return ((pb >> 2) ? OFF_CX : OFF_CC) + (tile - 4) * 128 + (pb & 3) * 32;
    if (tile < 14) { const int wc = pb & 3, bj = pb >> 2; return OFF_Q + (tile - 8) * 256 + 64 * wc + 32 * bj; }
    return OFF_V + (tile - 14) * 256 + pb * 32;
}
__device__ __forceinline__ void xprep_rows2(const float* x, bf16* xo, float* rsq, int row0, int row1, int lane) {
    const GAS f32x4* xa = (const GAS f32x4*)(x + (size_t)row0 * D) + lane; const GAS f32x4* xb = (const GAS f32x4*)(x + (size_t)row1 * D) + lane;
    f32x4 va[4], vb[4];
#pragma unroll
    for (int j = 0; j < 4; ++j) { va[j] = __builtin_nontemporal_load(xa + 64 * j); vb[j] = __builtin_nontemporal_load(xb + 64 * j); }
    float sa = 0.f, sb = 0.f;
#pragma unroll
    for (int j = 0; j < 4; ++j) { sa += (va[j].x * va[j].x + va[j].y * va[j].y) + (va[j].z * va[j].z + va[j].w * va[j].w); sb += (vb[j].x * vb[j].x + vb[j].y * vb[j].y) + (vb[j].z * vb[j].z + vb[j].w * vb[j].w); }
    sa = wave_sum(sa); sb = wave_sum(sb);
    GAS unsigned long long* oa = (GAS unsigned long long*)(xo + (size_t)row0 * D) + lane; GAS unsigned long long* ob = (GAS unsigned long long*)(xo + (size_t)row1 * D) + lane;
#pragma unroll
    for (int j = 0; j < 4; ++j) { oa[64 * j] = (unsigned long long)pk2(va[j].x, va[j].y) | ((unsigned long long)pk2(va[j].z, va[j].w) << 32);
                                  ob[64 * j] = (unsigned long long)pk2(vb[j].x, vb[j].y) | ((unsigned long long)pk2(vb[j].z, vb[j].w) << 32); }
    if (lane < 4) { rsq[(size_t)lane * M + row0] = (lane == 0) ? sa : 0.f; rsq[(size_t)lane * M + row1] = (lane == 0) ? sb : 0.f; }
}

struct LayerW {
    const float *norm_mix, *w_in, *b_gate, *pool_mix, *pool_scale, *conv_w, *q_gain, *k_gain, *w_pool_up, *w_conv_out, *w_attn_up, *w_o, *norm_mlp, *w_ff1, *w_ff2;
};

__device__ __forceinline__ void convert_weights(Frame& F, const LayerW& L, int part, int gw, int NGW) {
    LAS float* scr = (LAS float*)(F.lds + RING_OFF + F.wave * 16384);
    unsigned char* ws = F.ws;
    constexpr int I_WZ = (NZ / 32) * (D / 64), I_WG = (NG / 32) * (D / 64), I_CO = (D / 32) * (CW / 64), I_AU = (D / 32) * (AO / 64), I_WO = (D / 32) * (D / 64), I_W1 = (FF / 32) * (D / 64), I_W2 = (D / 32) * (FF / 64);
    if (part == 0) {
        for (int r = gw; r < I_WZ; r += NGW) { const int rb = r / (D / 64), kb = r % (D / 64); transpose_item(L.w_in, INC, kb * 64, wz_src_col(rb), (bf16*)(ws + WS_WZ), D, rb * 32, scr, F.lane, L.norm_mix); }
        return;
    }
    constexpr int NITEMS = I_WG + I_CO + I_AU + I_WO + I_W1 + I_W2;
    for (int it = gw; it < NITEMS; it += NGW) {
        int r = it;
        if (r < I_WG) { const int rb = r / (D / 64), kb = r % (D / 64); transpose_item(L.w_in, INC, kb * 64, OFF_G + rb * 32, (bf16*)(ws + WS_WG), D, rb * 32, scr, F.lane, L.norm_mix); continue; } r -= I_WG;
        if (r < I_CO) { const int rb = r / (CW / 64), kb = r % (CW / 64); transpose_item(L.w_conv_out, D, kb * 64, rb * 32, (bf16*)(ws + WS_WCO), CW, rb * 32, scr, F.lane); continue; } r -= I_CO;
        if (r < I_AU) { const int rb = r / (AO / 64), kb = r % (AO / 64); transpose_item(L.w_attn_up, D, kb * 64, rb * 32, (bf16*)(ws + WS_WAU), AO, rb * 32, scr, F.lane); continue; } r -= I_AU;
        if (r < I_WO) { const int rb = r / (D / 64), kb = r % (D / 64); transpose_item(L.w_o, D, kb * 64, rb * 32, (bf16*)(ws + WS_WO), D, rb * 32, scr, F.lane); continue; } r -= I_WO;
        if (r < I_W1) { const int rb = r / (D / 64), kb = r % (D / 64); transpose_item(L.w_ff1, FF, kb * 64, rb * 32, (bf16*)(ws + WS_W1), D, rb * 32, scr, F.lane, L.norm_mlp); continue; } r -= I_W1;
        { const int rb = r / (FF / 64), kb = r % (FF / 64); transpose_item(L.w_ff2, D, kb * 64, rb * 32, (bf16*)(ws + WS_W2), FF, rb * 32, scr, F.lane); }
    }
    for (int grp = gw >> 3; grp < (PW / 64) * (D / 32); grp += NGW >> 3) {
        const int kb = (grp / (D / 32)) * 8 + F.wave, nb = grp % (D / 32), k0 = kb * 8, g = k0 >> 7, n = nb * 32 + (F.lane & 31), dh = (F.lane >> 5) * 64;
        float a[8];
#pragma unroll
        for (int i = 0; i < 8; ++i) a[i] = 0.f;
        const float* mixr = L.pool_mix + (size_t)g * 128 * 128 + (size_t)(k0 & 127) * 128 + dh;
        const float* wp = L.w_pool_up + (size_t)(g * 128 + dh) * D + n; const float* sp = L.pool_scale + g * 128 + dh;
#pragma unroll 8
        for (int d = 0; d < 64; ++d) {
            const float wv = wp[(size_t)d * D] * sp[d];
#pragma unroll
            for (int i = 0; i < 8; ++i) a[i] += mixr[i * 128 + d] * wv;
        }
#pragma unroll
        for (int i = 0; i < 8; ++i) a[i] += __shfl_xor(a[i], 32);
        if (F.lane < 32) { v4u o; o.x = pk2(a[0], a[1]); o.y = pk2(a[2], a[3]); o.z = pk2(a[4], a[5]); o.w = pk2(a[6], a[7]);
            *(GAS v4u*)((bf16*)(ws + WS_WPU) + (size_t)n * PW + k0) = o; }
    }
}

template <int W> __device__ __forceinline__ void pool_run(const bf16* U, bf16* DP, int g, int run, int lane) {
    const int b = run >> 7, t0 = (run & 127) * 32; const size_t rowb = (size_t)b * SEQ;
    const int c = g * 128 + 2 * lane;
    unsigned w[32 + W];
#pragma unroll
    for (int k = 0; k < 32 + W; ++k) { const int tt = t0 - W + k; w[k] = (tt >= 0) ? *(const GAS unsigned*)(U + (rowb + tt) * PW + c) : 0u; }
    float s0 = 0.f, s1 = 0.f;
#pragma unroll
    for (int k = 0; k < W; ++k) { s0 += bf_lo(w[k]); s1 += bf_hi(w[k]); }
#pragma unroll
    for (int k = 0; k < 32; ++k) { const int t = t0 + k; const float n0 = bf_lo(w[W + k]), n1 = bf_hi(w[W + k]);
        s0 += n0 - bf_lo(w[k]); s1 += n1 - bf_hi(w[k]);
        const float inv = 1.0f / (float)((t + 1 < W) ? t + 1 : W);
        *(GAS unsigned*)(DP + (rowb + t) * PW + c) = pk2(s0 * inv - n0, s1 * inv - n1); }
}
__device__ __forceinline__ void conv_run(const bf16* U2, const bf16* CBp, const float* cw, bf16* YC, int run, int lane) {
    const int b = run >> 9, t0 = (run & 511) * 8; const size_t rowb = (size_t)b * SEQ; const int c = 8 * lane;
    v4u uw[10], bw[8];
    const int tw = t0 >= 2 ? t0 - 2 : 0;
    uw[0] = *(const GAS v4u*)(U2 + (rowb + tw) * CW + c); uw[1] = *(const GAS v4u*)(U2 + (rowb + tw + 1) * CW + c);
#pragma unroll
    for (int k = 0; k < 8; ++k) { uw[k + 2] = *(const GAS v4u*)(U2 + (rowb + t0 + k) * CW + c); bw[k] = *(const GAS v4u*)(CBp + (rowb + t0 + k) * CW + c); }
    float w0[8], w1[8], w2[8];
#pragma unroll
    for (int e = 0; e < 8; ++e) { w0[e] = cw[c + e]; w1[e] = cw[CW + c + e]; w2[e] = cw[2 * CW + c + e]; }
    asm volatile("" ::: "memory");
    if (t0 < 2) { uw[0] = (v4u){0u, 0u, 0u, 0u}; uw[1] = (v4u){0u, 0u, 0u, 0u}; }
#define CV_UNPK(q_, f_) do { const v4u t_ = (q_); f_[0] = bf_lo(t_.x); f_[1] = bf_hi(t_.x); f_[2] = bf_lo(t_.y); f_[3] = bf_hi(t_.y); f_[4] = bf_lo(t_.z); f_[5] = bf_hi(t_.z); f_[6] = bf_lo(t_.w); f_[7] = bf_hi(t_.w); } while (0)
#pragma unroll
    for (int k = 0; k < 8; ++k) { float p2[8], p1[8], u[8], bg[8], y[8];
        CV_UNPK(uw[k], p2); CV_UNPK(uw[k + 1], p1); CV_UNPK(uw[k + 2], u); CV_UNPK(bw[k], bg);
#pragma unroll
        for (int e = 0; e < 8; ++e) y[e] = bg[e] * (w2[e] * u[e] + w1[e] * p1[e] + w0[e] * p2[e]);
        v4u o; o.x = pk2(y[0], y[1]); o.y = pk2(y[2], y[3]); o.z = pk2(y[4], y[5]); o.w = pk2(y[6], y[7]);
        *(GAS v4u*)(YC + (rowb + t0 + k) * CW + c) = o; }
#undef CV_UNPK
}

constexpr int KPITCH = 144;
static_assert(384 * (192 + 144) <= RING_BYTES, "attention tiles");
constexpr int VPITCH = 192;
__device__ __forceinline__ int crow(int r, int hi) { return (r & 3) + 8 * (r >> 2) + 4 * hi; }
struct AttnCoord { int b, h, g, dil, rr, i0; };
__device__ __forceinline__ AttnCoord attn_decode(int unit) {
    AttnCoord c; c.b = unit / 192; const int rem = unit % 192; c.h = rem >> 4; const int s = rem & 15; c.g = c.h >> 2; const int lg = 2 * c.g; c.dil = 1 << lg;
    const int nub = 16 >> lg; c.rr = s / nub; c.i0 = (s % nub) * 256; return c;
}
__device__ __forceinline__ void attn_issue(const Frame& F, const AttnCoord& c, v4u (&vv)[6], v4u (&kk)[6], bf16x8 (&qn)[4]) {
    const bf16* Q = (const bf16*)(F.ws + WS_Q); const bf16* K = (const bf16*)(F.ws + WS_K); const bf16* V = (const bf16*)(F.ws + WS_V);
    const size_t rowb = (size_t)c.b * SEQ; const int tid = F.tid, r32 = F.lane & 31, hi = F.lane >> 5;
#pragma unroll
    for (int ps = 0; ps < 6; ++ps) { const int kl = ps * 64 + (tid >> 3), ch = tid & 7, ip = c.i0 - 128 + kl, ipc = ip < 0 ? 0 : ip;
        vv[ps] = *(const GAS v4u*)(V + (rowb + (size_t)ipc * c.dil + c.rr) * AW + c.h * HD + ch * 8);
        kk[ps] = *(const GAS v4u*)(K + (rowb + (size_t)ipc * c.dil + c.rr) * AW + c.h * HD + ch * 8); }
    const int iq = c.i0 + 32 * F.wave + r32;
    const bf16* qp = Q + (rowb + (size_t)iq * c.dil + c.rr) * AW + c.h * HD + 8 * hi;
#pragma unroll
    for (int d0 = 0; d0 < 4; ++d0) qn[d0] = *(const GAS bf16x8*)(qp + 16 * d0);
}
__device__ __forceinline__ void attn_units(Frame& F, int u0, int du, int nu, float Cc) {
    bf16* OP = (bf16*)(F.ws + WS_OP); float* LP = (float*)(F.ws + WS_LP);
    LAS unsigned char* Vs = F.lds + RING_OFF; LAS unsigned char* Ks = Vs + 384 * VPITCH;
    const int tid = F.tid, lane = F.lane, w = F.wave, r32 = lane & 31, hi = lane >> 5;
    v4u vv[6], kk[6]; bf16x8 qn[4];
    if (u0 < nu) attn_issue(F, attn_decode(u0), vv, kk, qn);
#pragma unroll 1
  for (int unit = u0; unit < nu; unit += du) {
    const AttnCoord c = attn_decode(unit);
    const int h = c.h, g = c.g, dil = c.dil, rr = c.rr, i0 = c.i0;
    const size_t rowb = (size_t)c.b * SEQ;
#pragma unroll
    for (int ps = 0; ps < 6; ++ps) { const int kl = ps * 64 + (tid >> 3), ch = tid & 7, ip = i0 - 128 + kl;
        v4u v = vv[ps]; if (ip < 0) v = (v4u){0u, 0u, 0u, 0u};
        *(LAS v4u*)(Vs + kl * VPITCH + ch * 16) = v;
        *(LAS v4u*)(Ks + kl * KPITCH + ch * 16) = kk[ps]; }
    const int iq = i0 + 32 * w + r32;
    bf16x8 qf[4];
#pragma unroll
    for (int d0 = 0; d0 < 4; ++d0) qf[d0] = qn[d0];
    LDS_BARRIER();
    if (unit + du < nu) attn_issue(F, attn_decode(unit + du), vv, kk, qn);
    const LAS unsigned char* kb = Ks + (32 * w + r32) * KPITCH + 16 * hi;
    bf16x8 kfn[4];
#pragma unroll
    for (int d0 = 0; d0 < 4; ++d0) kfn[d0] = *(const LAS bf16x8*)(kb + 32 * d0);
    f32x16 o0 = {}, o1 = {}; float lsum = 0.f;
    const int t4 = r32 - 4 * hi;
    const int trb = (4 * hi + ((lane & 15) >> 2)) * VPITCH + (16 * ((lane >> 4) & 1) + 4 * (lane & 3)) * 2;
#pragma unroll 1
    for (int kt = 0; kt < 5; ++kt) {
        const int kl0 = 32 * w + 32 * kt, ipb = i0 - 128 + kl0;
        bf16x8 kf[4];
#pragma unroll
        for (int d0 = 0; d0 < 4; ++d0) kf[d0] = kfn[d0];
        {
            const int ktn = kt < 4 ? kt + 1 : 4;
#pragma unroll
            for (int d0 = 0; d0 < 4; ++d0) kfn[d0] = *(const LAS bf16x8*)(kb + 32 * ktn * KPITCH + 32 * d0);
        }
        f32x16 sacc = {};
#pragma unroll
        for (int d0 = 0; d0 < 4; ++d0) sacc = __builtin_amdgcn_mfma_f32_32x32x16_bf16(kf[d0], qf[d0], sacc, 0, 0, 0);
        LAS unsigned char* vb = Vs + kl0 * VPITCH + trb;
        bf16x8 vf[4];
#pragma unroll
        for (int db = 0; db < 2; ++db)
#pragma unroll
            for (int st = 0; st < 2; ++st) {
                const s16x4 lo = __builtin_bit_cast(s16x4, __builtin_amdgcn_ds_read_tr16_b64_v4i16((LAS s16x4*)(vb + (16 * st) * VPITCH + db * 64)));
                const s16x4 hi4 = __builtin_bit_cast(s16x4, __builtin_amdgcn_ds_read_tr16_b64_v4i16((LAS s16x4*)(vb + (16 * st + 8) * VPITCH + db * 64)));
                vf[db * 2 + st] = (bf16x8){lo[0], lo[1], lo[2], lo[3], hi4[0], hi4[1], hi4[2], hi4[3]};
            }
        __builtin_amdgcn_sched_barrier(0);
        float p[16];
        if (ipb < 0) {
#pragma unroll
            for (int r = 0; r < 16; ++r) p[r] = 0.f;
        } else if (kt == 0) {
#pragma unroll
            for (int r = 0; r < 16; ++r) { p[r] = (t4 <= (r & 3) + 8 * (r >> 2)) ? __builtin_amdgcn_exp2f(sacc[r] - Cc) : 0.f; lsum += p[r]; }
        } else if (kt == 4) {
#pragma unroll
            for (int r = 0; r < 16; ++r) { p[r] = ((r & 3) + 8 * (r >> 2) <= t4) ? __builtin_amdgcn_exp2f(sacc[r] - Cc) : 0.f; lsum += p[r]; }
        } else {
#pragma unroll
            for (int r = 0; r < 16; ++r) { p[r] = __builtin_amdgcn_exp2f(sacc[r] - Cc); lsum += p[r]; }
        }
        v4u pb0, pb1;
        pb0.x = pk2(p[0], p[1]); pb0.y = pk2(p[2], p[3]); pb0.z = pk2(p[4], p[5]); pb0.w = pk2(p[6], p[7]);
        pb1.x = pk2(p[8], p[9]); pb1.y = pk2(p[10], p[11]); pb1.z = pk2(p[12], p[13]); pb1.w = pk2(p[14], p[15]);
        const bf16x8 pf0 = __builtin_bit_cast(bf16x8, pb0), pf1 = __builtin_bit_cast(bf16x8, pb1);
        asm volatile("" : "+v"(vf[0]), "+v"(vf[1]), "+v"(vf[2]), "+v"(vf[3]));
        o0 = __builtin_amdgcn_mfma_f32_32x32x16_bf16(vf[0], pf0, o0, 0, 0, 0);
        o0 = __builtin_amdgcn_mfma_f32_32x32x16_bf16(vf[1], pf1, o0, 0, 0, 0);
        o1 = __builtin_amdgcn_mfma_f32_32x32x16_bf16(vf[2], pf0, o1, 0, 0, 0);
        o1 = __builtin_amdgcn_mfma_f32_32x32x16_bf16(vf[3], pf1, o1, 0, 0, 0);
    }
    lsum += __shfl_xor(lsum, 32);
    const size_t orow = rowb + (size_t)iq * dil + rr;
    bf16* op = OP + ((size_t)g * M + orow) * AO + (h & 3) * HD;
#pragma unroll
    for (int pr = 0; pr < 4; ++pr) {
        const int ra = 2 * (pr & 1), rb = ra + 1;
        unsigned ax, ay, bx, by;
        if (pr < 2) { ax = pk2(o0[4 * ra], o0[4 * ra + 1]); ay = pk2(o0[4 * ra + 2], o0[4 * ra + 3]); bx = pk2(o0[4 * rb], o0[4 * rb + 1]); by = pk2(o0[4 * rb + 2], o0[4 * rb + 3]); }
        else        { ax = pk2(o1[4 * ra], o1[4 * ra + 1]); ay = pk2(o1[4 * ra + 2], o1[4 * ra + 3]); bx = pk2(o1[4 * rb], o1[4 * rb + 1]); by = pk2(o1[4 * rb + 2], o1[4 * rb + 3]); }
        { const auto r = __builtin_amdgcn_permlane32_swap(ax, bx, false, false); ax = r[0]; bx = r[1]; }
        { const auto r = __builtin_amdgcn_permlane32_swap(ay, by, false, false); ay = r[0]; by = r[1]; }
        v4u o; o.x = ax; o.y = ay; o.z = bx; o.w = by;
        *(GAS v4u*)(op + (pr < 2 ? 0 : 32) + 8 * ra + 8 * hi) = o; }
    if (hi == 0) LP[((size_t)g * M + orow) * 4 + (h & 3)] = lsum;
    LDS_BARRIER();
  }
}
__device__ __forceinline__ void combine_panel(Frame& F, int pm) {
    const bf16* OP = (const bf16*)(F.ws + WS_OP); const float* LP = (const float*)(F.ws + WS_LP); bf16* YA = (bf16*)(F.ws + WS_H + HC_YA + (size_t)pm * (HC_BYTES - 256 * AO * 2));
#pragma unroll 1
    for (int it0 = F.tid; it0 < 256 * 32; it0 += 4 * NTHREADS) {
        v4u w[4][3]; float lp[4][3];
#pragma unroll
        for (int q = 0; q < 4; ++q) { const int it = it0 + q * NTHREADS, m = pm * 256 + (it >> 5), ch = it & 31, j = ch >> 3;
#pragma unroll
            for (int g = 0; g < 3; ++g) { w[q][g] = *(const GAS v4u*)(OP + ((size_t)g * M + m) * AO + ch * 8); lp[q][g] = LP[((size_t)g * M + m) * 4 + j]; } }
        asm volatile("" ::: "memory");
#pragma unroll
        for (int q = 0; q < 4; ++q) { const int it = it0 + q * NTHREADS, m = pm * 256 + (it >> 5), ch = it & 31;
            float acc[8];
#pragma unroll
            for (int e = 0; e < 8; ++e) acc[e] = 0.f;
#pragma unroll
            for (int g = 0; g < 3; ++g) { const v4u x = w[q][g];
                acc[0] += bf_lo(x.x); acc[1] += bf_hi(x.x); acc[2] += bf_lo(x.y); acc[3] += bf_hi(x.y); acc[4] += bf_lo(x.z); acc[5] += bf_hi(x.z); acc[6] += bf_lo(x.w); acc[7] += bf_hi(x.w); }
            const float inv = 1.0f / ((lp[q][0] + lp[q][1]) + lp[q][2]);
            v4u o; o.x = pk2(acc[0] * inv, acc[1] * inv); o.y = pk2(acc[2] * inv, acc[3] * inv); o.z = pk2(acc[4] * inv, acc[5] * inv); o.w = pk2(acc[6] * inv, acc[7] * inv);
            *(GAS v4u*)(YA + (size_t)m * AO + ch * 8) = o; }
    }
}
__device__ __forceinline__ void rstd_panel_to_lds(Frame& F, int pm) {
    if (F.tid < 256) { const float* rsq = (const float*)(F.ws + WS_RSQ) + pm * 256 + F.tid;
        const float s4 = (rsq[0] + rsq[M]) + (rsq[2 * M] + rsq[3 * M]);
        ((LAS float*)(F.lds + RSTAB_OFF))[F.tid] = __builtin_amdgcn_rsqf(s4 * (1.0f / D) + RMS_EPS); }
    LDS_WAIT(); __syncthreads();
}
__device__ __forceinline__ void my_panel(int c, int& pm, int& q) { pm = 8 * (c & 7) + ((c >> 3) & 7); q = c >> 6; }
struct P1Sched {
    static constexpr bool HOOK = true;
    int pm, q; const bf16* A; const bf16* Bt; XcdBarrier xb; unsigned* base; unsigned round;
    __device__ __forceinline__ void unit_done(int ui, int wave) const { if (ui == 3) split_arrive(xb, wave, base, round); }
    __device__ __forceinline__ bool next(int i, pg8::UnitV& u) const {
        const int pn = q + 4 * i; if (pn >= NZ / 256) return false;
        int pm_ = pm; asm volatile("" : "+s"(pm_));
        u.pm = pm_; u.pn = pn; u.A = A; u.Bt = Bt; u.K = D; u.tag = 0; return true;
    }
};
struct P34Sched {
    static constexpr bool HOOK = false;
    int pm, pn; unsigned char* ws;
    __device__ __forceinline__ bool next(int i, pg8::UnitV& u) const {
        if (i >= ((DUP == 51) ? 7 : 6)) return false;
        if (i == 6) i = 4;
        const int br = i >> 1; int pm_ = pm, pn_ = pn; asm volatile("" : "+s"(pm_), "+s"(pn_));
        u.pm = pm_;
        if (!(i & 1)) { u.pn = 4 * br + pn_; u.A = (const bf16*)(ws + WS_XN); u.Bt = (const bf16*)(ws + WS_WG); u.K = D; u.tag = 2 * br + 1; }
        else { const size_t oa = (br == 0) ? WS_DP : (br == 1) ? WS_YC : WS_H + HC_YA + (size_t)pm_ * (HC_BYTES - 256 * AO * 2), ob = (br == 0) ? WS_WPU : (br == 1) ? WS_WCO : WS_WAU;
               u.pn = pn_; u.A = (const bf16*)(ws + oa); u.Bt = (const bf16*)(ws + ob); u.K = (br == 2) ? AO : PW; u.tag = 2 * br; }
        return true;
    }
};

struct Args { const float* in[16]; float* out; unsigned char* ws; };
#define PHASE_BEGIN() Frame F = F0; int lq = l; { int w_ = F0.wave; asm volatile("" : "+s"(w_)); unsigned o_ = ~0u; asm volatile("" : "+s"(o_)); int t_ = w_ * 64 + (int)__builtin_amdgcn_mbcnt_hi(o_, __builtin_amdgcn_mbcnt_lo(o_, 0u)); asm volatile("" : "+v"(t_)); asm volatile("" : "+s"(lq)); F.tid = t_; F.lane = t_ & 63; F.wave = __builtin_amdgcn_readfirstlane(t_ >> 6); } \
    unsigned char* const ws = F.ws; const int gw = F.vcu * NWAVES + F.wave, NGW = F.G * NWAVES; (void)gw; (void)NGW; (void)ws
#define LIN(k, stride) (args.in[k] + (size_t)lq * (stride))
__global__ void __launch_bounds__(NTHREADS, 2) mega_fwd(Args args) {
    extern __shared__ __attribute__((aligned(16))) unsigned char lds[];
    Frame F0;
    F0.lds = (LAS unsigned char*)lds;
    F0.MISC = (volatile LAS unsigned*)(F0.lds + MISC_OFF);
    F0.tid = threadIdx.x; F0.lane = F0.tid & 63; F0.wave = __builtin_amdgcn_readfirstlane(F0.tid >> 6);
    F0.G = gridDim.x; { const int bx = blockIdx.x; F0.vcu = (F0.G % 8 == 0) ? (bx % 8) * (F0.G / 8) + bx / 8 : bx; }
    F0.ws = args.ws; F0.ctl = (gu32*)(args.ws + WS_CTL);
    for (int u = F0.tid; u < (LDS_BYTES - LDSCTL_OFF) / 4; u += NTHREADS) ((LAS unsigned*)(F0.lds + LDSCTL_OFF))[u] = 0u;
    __syncthreads();
    unsigned* const bar_base = (unsigned*)(F0.ctl + CW_BAR);
    XcdBarrier bar = xcd_barrier_post(bar_base, F0.MISC + 8, F0.wave);
    if (F0.wave == 0 && xb_lane0()) (void)xb_add((unsigned*)(F0.ctl + CW_XID) + blockIdx.x, bar.x + 1u);
#define GRID_BAR() do { int w_ = F0.wave; unsigned o_ = CW_BAR; asm volatile("" : "+s"(w_), "+s"(o_)); bar.wave = w_; bar.bar = (unsigned*)(F0.ctl + o_); xcd_barrier(bar); } while (0)
#define EXEC_BAR() do { int w_ = F0.wave; unsigned o_ = CW_BAR; asm volatile("" : "+s"(w_), "+s"(o_)); bar.wave = w_; bar.bar = (unsigned*)(F0.ctl + o_); xcd_barrier<false>(bar); } while (0)
#define GROUP_BAR(n) do { int w_ = F0.wave; unsigned o_ = 0u; asm volatile("" : "+s"(w_), "+s"(o_)); bar.wave = w_; unsigned* const cb_ = (unsigned*)(F0.ctl + o_); bar.bar = cb_ + CW_BAR; \
        group_barrier(bar, cb_ + CW_GRP + 64 * ((int)blockIdx.x & 63), 4u * (unsigned)(n), cb_ + CW_XID + ((int)blockIdx.x & 63)); } while (0)

#pragma unroll 1
    for (int l = 0; l < DEPTH; ++l) {
#define LAYERW(L) LayerW L; L.norm_mix = LIN(1, D); L.w_in = LIN(2, (size_t)D * INC); L.pool_mix = LIN(4, 4 * 128 * 128); L.pool_scale = LIN(5, PW); \
            L.w_pool_up = LIN(9, (size_t)PW * D); L.w_conv_out = LIN(10, (size_t)CW * D); L.w_attn_up = LIN(11, (size_t)AO * D); L.w_o = LIN(12, (size_t)D * D); \
            L.w_ff1 = LIN(14, (size_t)D * FF); L.w_ff2 = LIN(15, (size_t)FF * D); L.norm_mlp = LIN(13, D)
        REPS(0) {
            PHASE_BEGIN();
            LAYERW(L);
            convert_weights(F, L, 0, gw, NGW);
            if (lq > 0) {
                unsigned og_ = CW_G0, ol_ = CW_LE; asm volatile("" : "+s"(og_), "+s"(ol_));
                split_arrive<true>(bar, F.wave, (unsigned*)(F0.ctl + og_), (unsigned)lq);
                split_wait<false>(bar, F.wave, (unsigned*)(F0.ctl + ol_), (unsigned)lq);
            }
#ifdef CONV_IN_P0
            convert_weights(F, L, 1, gw, NGW);
#endif
            if (lq == 0) for (int m = gw; m < M; m += 2 * NGW) xprep_rows2(args.in[0], (bf16*)(ws + WS_XN), (float*)(ws + WS_RSQ), m, m + NGW, F.lane);
        }
        if (l == 0) GRID_BAR();
        else { int w_ = F0.wave; unsigned og_ = CW_G0; asm volatile("" : "+s"(w_), "+s"(og_)); split_wait<true>(bar, w_, (unsigned*)(F0.ctl + og_), (unsigned)l); }

        REPS(1) {
            PHASE_BEGIN();
            int pm0, q0; my_panel((int)blockIdx.x, pm0, q0);
            rstd_panel_to_lds(F, pm0);
            unsigned o1_ = CW_P1; asm volatile("" : "+s"(o1_)); unsigned* const p1b = (unsigned*)(F0.ctl + o1_);
            P1Sched S{pm0, q0, (const bf16*)(ws + WS_XN), (const bf16*)(ws + WS_WZ), bar, p1b, (unsigned)lq + 1u};
            pg8::EpiZ E{(bf16*)(ws + WS_U), (bf16*)(ws + WS_CB), (bf16*)(ws + WS_U2), (bf16*)(ws + WS_Q), (bf16*)(ws + WS_K), (bf16*)(ws + WS_V), LIN(7, HD), LIN(8, HD), (const LAS float*)(F.lds + RSTAB_OFF)};
            pg8::gemm_phase_v<pg8::EpiZ, P1Sched, ALIGN_MULTI>(F.lds + RING_OFF, S, E, F.tid, ws);
            if (q0 != 0) {
                split_arrive(bar, F.wave, p1b, (unsigned)lq + 1u); split_wait(bar, F.wave, p1b, (unsigned)lq + 1u);
                const int gw2 = ((q0 - 1) * 64 + ((int)blockIdx.x & 63)) * NWAVES + F.wave, NGW2 = 192 * NWAVES;
                for (int it = gw2; it < 2048; it += NGW2) { const int g = it & 3, run = it >> 2; const bf16* U = (const bf16*)(ws + WS_U); bf16* DP = (bf16*)(ws + WS_DP);
                    if (g == 0) pool_run<2>(U, DP, 0, run, F.lane); else if (g == 1) pool_run<4>(U, DP, 1, run, F.lane); else if (g == 2) pool_run<8>(U, DP, 2, run, F.lane); else pool_run<16>(U, DP, 3, run, F.lane); }
                for (int it = gw2; it < 2048; it += NGW2) conv_run((const bf16*)(ws + WS_U2), (const bf16*)(ws + WS_CB), LIN(6, 3 * CW), (bf16*)(ws + WS_YC), it, F.lane);
            }
#ifndef CONV_IN_P0
            constexpr int NFIVE = (M / 256) * (NZ / 256) - 4 * 256;
            if (F.G == 256 && (int)blockIdx.x >= NFIVE) { LAYERW(L); convert_weights(F, L, 1, ((int)blockIdx.x - NFIVE) * NWAVES + F.wave, (256 - NFIVE) * NWAVES); }
            else if (F.G != 256) { LAYERW(L); convert_weights(F, L, 1, gw, NGW); }
#endif
        }
        GRID_BAR();

        REPS(2) {
            PHASE_BEGIN();
            float gg = fabsf(LIN(7, HD)[F.lane] * LIN(8, HD)[F.lane]); gg = wave_max(gg);
            const float Cc = 8.0f * 1.4426950408889634f * gg;
            attn_units(F, F.vcu, F.G, BATCH * NH * 16, Cc);
        }
        GRID_BAR();

        REPS(3) {
            PHASE_BEGIN();
            pg8::StaticOrder so; so.init(M, D, F.G, (int)blockIdx.x); pg8::Unit t0; so.next(0, t0);
            REPS(33) combine_panel(F, t0.pm);
            VM_WAIT();
            for (int i = F.tid; i < 3 * 256; i += NTHREADS) ((LAS float*)(F.lds + BTAB_OFF))[i] = -1.4426950408889634f * LIN(3, 3 * D)[(i >> 8) * D + t0.pn * 256 + (i & 255)];
            rstd_panel_to_lds(F, t0.pm);
            P34Sched S{t0.pm, t0.pn, ws};
            pg8::EpiP34 E{(bf16*)(ws + WS_H + HC_MG + (size_t)t0.pm * (HC_BYTES - 256 * D * 2)), (pg8::u32x4*)(ws + WS_H + HC_GS + (size_t)t0.pm * HC_BYTES) + (size_t)t0.pn * 8192, (const LAS float*)(F.lds + BTAB_OFF), (const LAS float*)(F.lds + RSTAB_OFF)};
            pg8::gemm_phase_v<pg8::EpiP34, P34Sched, ALIGN_MULTI>(F.lds + RING_OFF, S, E, F.tid, ws);
        }
        GROUP_BAR(3 * l + 1);

        {
            PHASE_BEGIN();
            int pm5, q5; my_panel((int)blockIdx.x, pm5, q5);
            pg8::UniformSched S; S.init((const bf16*)(ws + WS_H + HC_MG + (size_t)pm5 * (HC_BYTES - 256 * D * 2)), (const bf16*)(ws + WS_WO), M, D, D, F.G, (int)blockIdx.x);
            pg8::EpiResNorm E{(bf16*)(ws + WS_XN), (float*)nullptr, (float*)(ws + WS_RSQ)};
            pg8::gemm_phase_v<pg8::EpiResNorm, pg8::UniformSched, false>(F.lds + RING_OFF, S, E, F.tid, ws);
        }
        GROUP_BAR(3 * l + 2);
        REPS(6) {
            PHASE_BEGIN();
            pg8::UniformSched S; S.init((const bf16*)(ws + WS_XN), (const bf16*)(ws + WS_W1), M, FF, D, F.G, (int)blockIdx.x);
            { int pm6, q6; my_panel((int)blockIdx.x, pm6, q6); rstd_panel_to_lds(F, pm6); }
            pg8::EpiRelu2 E{(bf16*)(ws + WS_H), (const LAS float*)(F.lds + RSTAB_OFF)};
            pg8::gemm_phase_v<pg8::EpiRelu2, pg8::UniformSched, ALIGN_MULTI>(F.lds + RING_OFF, S, E, F.tid, ws);
        }
        GROUP_BAR(3 * l + 3);
        REPS(40) { if (DUP == 40) { GRID_BAR(); GRID_BAR(); } }
        {
            PHASE_BEGIN();
            pg8::UniformSched S; S.init((const bf16*)(ws + WS_H), (const bf16*)(ws + WS_W2), M, D, FF, F.G, (int)blockIdx.x);
            const bool more = (lq + 1 < DEPTH);
            pg8::EpiResNorm E{(bf16*)(ws + WS_XN), more ? (float*)nullptr : args.out, (float*)(ws + WS_RSQ)};
            pg8::gemm_phase_v<pg8::EpiResNorm, pg8::UniformSched, false>(F.lds + RING_OFF, S, E, F.tid, ws);
        }
        if (l + 1 < DEPTH) { int w_ = F0.wave; unsigned ol_ = CW_LE; asm volatile("" : "+s"(w_), "+s"(ol_)); split_arrive<false>(bar, w_, (unsigned*)(F0.ctl + ol_), (unsigned)l + 1u); }
    }
}

extern "C" void kernel_launch(void* const* d_in, const int* in_sizes, int n_in, void* d_out, int out_size, void* d_ws, size_t ws_size, hipStream_t stream) {
    static int grid = 0;
    if (grid == 0) {
        if (n_in != 16 || in_sizes[0] != M * D || out_size != M * D || ws_size < WS_END) { fprintf(stderr, "kernel_launch: unexpected shapes (n_in %d, in0 %d, out %d, ws %zu)\n", n_in, n_in > 0 ? in_sizes[0] : -1, out_size, ws_size); grid = -1; return; }
        int dev = 0, cus = 0, per_cu = 0;
        if (hipGetDevice(&dev) != hipSuccess || hipDeviceGetAttribute(&cus, hipDeviceAttributeMultiprocessorCount, dev) != hipSuccess) { grid = -1; return; }
        if (hipFuncSetAttribute((const void*)mega_fwd, hipFuncAttributeMaxDynamicSharedMemorySize, LDS_BYTES) != hipSuccess) { fprintf(stderr, "kernel_launch: hipFuncSetAttribute failed\n"); grid = -1; return; }
        if (hipOccupancyMaxActiveBlocksPerMultiprocessor(&per_cu, (const void*)mega_fwd, NTHREADS, LDS_BYTES) != hipSuccess || per_cu < 1) fprintf(stderr, "kernel_launch: occupancy query reports %d\n", per_cu);
        (void)hipGetLastError();
        grid = cus;
        if (grid != 256) fprintf(stderr, "kernel_launch: built for a 256-CU device (one output tile per workgroup in three phases); got %d CUs: results will be wrong\n", grid);
    }
    if (grid < 0) return;
    if (hipMemsetAsync((char*)d_ws + WS_CTL, 0, CTL_ZERO_BYTES, stream) != hipSuccess) { fprintf(stderr, "kernel_launch: memset failed\n"); return; }
    Args a{};
    for (int i = 0; i < 16; ++i) a.in[i] = (const float*)d_in[i];
    a.out = (float*)d_out; a.ws = (unsigned char*)d_ws;
    hipLaunchKernelGGL(mega_fwd, dim3(grid), dim3(NTHREADS), LDS_BYTES, stream, a);
    const hipError_t le = hipPeekAtLastError();
    if (le != hipSuccess) fprintf(stderr, "kernel_launch: launch failed: %s\n", hipGetErrorName(le));
}
```
